# Optimizing an MI355X kernel written in HIP

```python
import math
import jax, jax.numpy as jnp
from jax import lax
import numpy as np

D_MODEL = 1024
BATCH = 8
SEQ = 2048
DEPTH = 4

ROPE_THETA = 10000.0
NORM_EPS = 1e-6

BRANCH_W = D_MODEL // 2
N_BRANCH = 3

GLA_HEADS = 4
GLA_DV = BRANCH_W // GLA_HEADS
GLA_DK = GLA_DV // 2
GLA_RANK = 16
GLA_TAU = 16.0
GLA_CHUNK = 64
GLA_QK_W = GLA_HEADS * GLA_DK

DIFF_HEADS = 4
DIFF_D = BRANCH_W // (2 * DIFF_HEADS)
DIFF_QK_W = DIFF_HEADS * 2 * DIFF_D
DIFF_QBLOCK = 128

DIL_HEADS = 8
DIL_HD = BRANCH_W // DIL_HEADS
DIL_W = DIL_HEADS * DIL_HD
DIL_PATTERNS = ((128, 1), (512, 4), (2048, 16))
DIL_QBLOCK = 64

IN_SPLITS = (
    GLA_QK_W, GLA_QK_W, BRANCH_W, BRANCH_W, GLA_RANK, GLA_RANK,
    DIFF_QK_W, DIFF_QK_W, BRANCH_W, BRANCH_W,
    DIL_W, DIL_W, BRANCH_W, BRANCH_W,
    N_BRANCH * D_MODEL,
)
IN_COLS = sum(IN_SPLITS)

kernel_name = "hybrid_gla_diff_dilated_encoder"


def rms_norm(x, g):
    xf = x.astype(jnp.float32)
    y = xf * lax.rsqrt(jnp.mean(xf * xf, axis=-1, keepdims=True) + NORM_EPS)
    return (y * g.astype(jnp.float32)).astype(x.dtype)


def rope_tables(seq, dim):
    inv = 1.0 / (ROPE_THETA ** (jnp.arange(0, dim, 2, dtype=jnp.float32) / dim))
    ang = jnp.arange(seq, dtype=jnp.float32)[:, None] * inv[None, :]
    return jnp.cos(ang), jnp.sin(ang)


def apply_rope(x, cos, sin):
    x1, x2 = jnp.split(x.astype(jnp.float32), 2, axis=-1)
    return jnp.concatenate([x1 * cos - x2 * sin, x2 * cos + x1 * sin], axis=-1).astype(x.dtype)


def split_points():
    pts, acc = [], 0
    for s in IN_SPLITS[:-1]:
        acc += s
        pts.append(acc)
    return pts


def gla_one_direction(q, k, v, log_a):
    B, H, S, DK = q.shape
    DV = v.shape[-1]
    C = GLA_CHUNK
    N = S // C
    q = q.reshape(B, H, N, C, DK)
    k = k.reshape(B, H, N, C, DK)
    v = v.reshape(B, H, N, C, DV)
    b = jnp.cumsum(log_a.reshape(B, H, N, C, DK), axis=3)
    b_last = b[:, :, :, -1:, :]
    q_hat = q * jnp.exp(b)
    k_hat = k * jnp.exp(-b)
    tri = jnp.tril(jnp.ones((C, C), dtype=bool))
    att = jnp.where(tri, jnp.einsum('bhncd,bhnjd->bhncj', q_hat, k_hat), 0.0)
    o_intra = jnp.einsum('bhncj,bhnje->bhnce', att, v)
    k_end = k * jnp.exp(b_last - b)
    upd = jnp.einsum('bhncd,bhnce->nbhde', k_end, v)
    decay = jnp.moveaxis(jnp.exp(b_last[:, :, :, 0, :]), 2, 0)[..., None]

    def step(state, inp):
        d, u = inp
        return d * state + u, state

    _, s_in = lax.scan(step, jnp.zeros((B, H, DK, DV), q.dtype), (decay, upd))
    o_inter = jnp.einsum('bhncd,nbhde->bhnce', q_hat, s_in)
    return (o_intra + o_inter).reshape(B, H, S, DV)


def diff_attention(q, k, v, lam):
    B, H, _, S, d = q.shape
    nb = S // DIFF_QBLOCK
    qb = jnp.moveaxis(q.reshape(B, H, 2, nb, DIFF_QBLOCK, d), 3, 0)
    scale = d ** -0.5

    def block(qblk):
        s = jnp.einsum('bhtqd,bhtkd->bhtqk', qblk, k, preferred_element_type=jnp.float32) * scale
        p = jax.nn.softmax(s, axis=-1)
        w = p[:, :, 0] - lam * p[:, :, 1]
        return jnp.einsum('bhqk,bhke->bhqe', w.astype(v.dtype), v)

    o = lax.map(block, qb)
    return jnp.moveaxis(o, 0, 2).reshape(B, H, S, 2 * d)


def dilated_window_attention(q, k, v, dilation, half):
    B, H, S, hd = q.shape
    Sr = S // dilation
    bq = math.gcd(DIL_QBLOCK, Sr)
    nb = Sr // bq
    L = bq + 2 * half

    def to_classes(t):
        return t.reshape(B, H, Sr, dilation, hd).transpose(0, 1, 3, 2, 4)

    qc, kc, vc = to_classes(q), to_classes(k), to_classes(v)
    pad = ((0, 0), (0, 0), (0, 0), (half, half), (0, 0))
    kp = jnp.pad(kc, pad)
    vp = jnp.pad(vc, pad)
    idx = (jnp.arange(nb) * bq)[:, None] + jnp.arange(L)[None, :]
    kb = kp[:, :, :, idx, :]
    vb = vp[:, :, :, idx, :]
    qb = qc.reshape(B, H, dilation, nb, bq, hd)
    s = jnp.einsum('bhrnqd,bhrnld->bhrnql', qb, kb, preferred_element_type=jnp.float32) * (hd ** -0.5)
    rel = jnp.arange(L)[None, :] - half - jnp.arange(bq)[:, None]
    src = idx[:, None, :] - half
    valid = (jnp.abs(rel) <= half)[None] & (src >= 0) & (src < Sr)
    s = jnp.where(valid, s, -1e30)
    lse = jax.nn.logsumexp(s, axis=-1)
    p = jnp.exp(s - lse[..., None])
    o = jnp.einsum('bhrnql,bhrnld->bhrnqd', p.astype(v.dtype), vb)
    o = o.reshape(B, H, dilation, Sr, hd).transpose(0, 1, 3, 2, 4).reshape(B, H, S, hd)
    lse = lse.reshape(B, H, dilation, Sr).transpose(0, 1, 3, 2).reshape(B, H, S)
    return o, lse


def hybrid_layer(x, layer, cos_b, sin_b, cos_c, sin_c, norm_g, w_in, gla_gate_up, gla_gate_b,
                 gla_norm_g, diff_lambda, diff_norm_g, w_branch, w_out):
    B, S, _ = x.shape
    f32 = jnp.float32
    h = rms_norm(x, norm_g)
    proj = jnp.einsum('bsd,dc->bsc', h, w_in)
    (a_q, a_k, a_v, a_g, a_lf, a_lb,
     b_q, b_k, b_v, b_g,
     c_q, c_k, c_v, c_g, merge) = jnp.split(proj, split_points(), axis=-1)

    def heads(t, n):
        return t.reshape(B, S, n, -1).transpose(0, 2, 1, 3)

    qa = heads(a_q, GLA_HEADS).astype(f32) * (GLA_DK ** -0.5)
    ka = heads(a_k, GLA_HEADS).astype(f32)
    va = heads(a_v, GLA_HEADS).astype(f32)
    la_f = heads(jax.nn.log_sigmoid((a_lf @ gla_gate_up[0] + gla_gate_b[0]).astype(f32)) / GLA_TAU, GLA_HEADS)
    la_b = heads(jax.nn.log_sigmoid((a_lb @ gla_gate_up[1] + gla_gate_b[1]).astype(f32)) / GLA_TAU, GLA_HEADS)
    flip = lambda t: jnp.flip(t, axis=2)
    o_a = gla_one_direction(qa, ka, va, la_f) + flip(gla_one_direction(flip(qa), flip(ka), flip(va), flip(la_b)))
    o_a = rms_norm(o_a.transpose(0, 2, 1, 3), gla_norm_g).reshape(B, S, BRANCH_W).astype(x.dtype)
    y_a = o_a * jax.nn.silu(a_g)

    qb = apply_rope(b_q.reshape(B, S, DIFF_HEADS, 2, DIFF_D).transpose(0, 2, 3, 1, 4), cos_b, sin_b)
    kb = apply_rope(b_k.reshape(B, S, DIFF_HEADS, 2, DIFF_D).transpose(0, 2, 3, 1, 4), cos_b, sin_b)
    vb = heads(b_v, DIFF_HEADS)
    lam_init = 0.8 - 0.6 * math.exp(-0.3 * layer)
    dl = diff_lambda.astype(f32)
    lam = jnp.exp(jnp.sum(dl[0] * dl[1])) - jnp.exp(jnp.sum(dl[2] * dl[3])) + lam_init
    o_b = diff_attention(qb, kb, vb, lam)
    o_b = rms_norm(o_b.transpose(0, 2, 1, 3), diff_norm_g) * (1.0 - lam_init)
    y_b = o_b.reshape(B, S, BRANCH_W).astype(x.dtype) * jax.nn.silu(b_g)

    qc = apply_rope(heads(c_q, DIL_HEADS), cos_c, sin_c)
    kc = apply_rope(heads(c_k, DIL_HEADS), cos_c, sin_c)
    vc = heads(c_v, DIL_HEADS)
    outs, lses = [], []
    for window, dil in DIL_PATTERNS:
        o_g, lse_g = dilated_window_attention(qc, kc, vc, dil, window // (2 * dil))
        outs.append(o_g)
        lses.append(lse_g)
    wts = jax.nn.softmax(jnp.stack(lses, axis=0), axis=0)
    o_c = jnp.einsum('gbhs,gbhsd->bhsd', wts, jnp.stack(outs, axis=0).astype(f32))
    y_c = o_c.transpose(0, 2, 1, 3).reshape(B, S, BRANCH_W).astype(x.dtype) * jax.nn.silu(c_g)

    y = jnp.stack([y_a, y_b, y_c], axis=2)
    z = jnp.einsum('bsgw,gwd->bsgd', y, w_branch)
    gates = jax.nn.sigmoid(merge.reshape(B, S, N_BRANCH, D_MODEL))
    mixed = jnp.sum(gates * z, axis=2)
    return x + jnp.einsum('bsd,de->bse', mixed, w_out)


def setup_inputs(seed: int = 0) -> dict:
    key = jax.random.key(seed)
    ks = jax.random.split(key, 12)
    nrm = jax.random.normal
    return {
        "x": nrm(ks[0], (BATCH, SEQ, D_MODEL), jnp.float32),
        "norm_g": 1.0 + 0.02 * nrm(ks[1], (DEPTH, D_MODEL), jnp.float32),
        "w_in": nrm(ks[2], (DEPTH, D_MODEL, IN_COLS), jnp.float32) * D_MODEL ** -0.5,
        "gla_gate_up": nrm(ks[3], (DEPTH, 2, GLA_RANK, GLA_QK_W), jnp.float32) * GLA_RANK ** -0.5,
        "gla_gate_b": 0.02 * nrm(ks[4], (DEPTH, 2, GLA_QK_W), jnp.float32),
        "gla_norm_g": 1.0 + 0.02 * nrm(ks[5], (DEPTH, GLA_DV), jnp.float32),
        "diff_lambda": 0.1 * nrm(ks[6], (DEPTH, 4, DIFF_D), jnp.float32),
        "diff_norm_g": 1.0 + 0.02 * nrm(ks[7], (DEPTH, 2 * DIFF_D), jnp.float32),
        "w_branch": nrm(ks[8], (DEPTH, N_BRANCH, BRANCH_W, D_MODEL), jnp.float32) * BRANCH_W ** -0.5,
        "w_out": nrm(ks[9], (DEPTH, D_MODEL, D_MODEL), jnp.float32) * D_MODEL ** -0.5,
        "final_norm_g": 1.0 + 0.02 * nrm(ks[10], (D_MODEL,), jnp.float32),
    }


def reference(x, norm_g, w_in, gla_gate_up, gla_gate_b, gla_norm_g, diff_lambda, diff_norm_g,
              w_branch, w_out, final_norm_g):
    S = x.shape[1]
    cos_b, sin_b = rope_tables(S, DIFF_D)
    cos_c, sin_c = rope_tables(S, DIL_HD)
    for layer in range(DEPTH):
        x = hybrid_layer(x, layer, cos_b, sin_b, cos_c, sin_c, norm_g[layer], w_in[layer],
                         gla_gate_up[layer], gla_gate_b[layer], gla_norm_g[layer],
                         diff_lambda[layer], diff_norm_g[layer], w_branch[layer], w_out[layer])
    return rms_norm(x, final_norm_g)
```

```cpp
#include <hip/hip_runtime.h>
#include <hip/hip_cooperative_groups.h>
#include <cstdio>
#include <cstdint>
namespace cg = cooperative_groups;

#ifndef SELF_POISON
#define SELF_POISON 0
#endif
#ifndef INPROJ_ALIGN
#define INPROJ_ALIGN true
#endif
#ifndef PROBE_REP
#define PROBE_REP 0
#endif
#ifndef DBG_W
#define DBG_W 0
#define DBG_IN 0
#define DBG_GLA 1
#define DBG_DIFF 0
#define DBG_DIL 1
#define DBG_MERGE 1
#define DBG_OUT 1
#endif
#ifndef DBG_ENC
#define DBG_ENC 0
#endif
#ifndef DBG_SP2
#define DBG_SP2 true
#endif
#ifndef DEBUG_CHECK
#define DEBUG_CHECK 0
#endif

namespace pg8 {
#define PG8_LAS __attribute__((address_space(3)))
typedef unsigned short bf16_t;
typedef short bf16x8 __attribute__((ext_vector_type(8)));
typedef float f32x4 __attribute__((ext_vector_type(4)));
typedef unsigned u32x4 __attribute__((ext_vector_type(4)));
constexpr int BM = 256, BK = 64, HALF = 128, HTB = HALF * BK * 2  , STAGE_BYTES = 8 * HTB, NXCD = 8, WGM = 8;

__host__ __device__ __forceinline__ int lds_byte(int r, int c) { const int st = (r >> 4) * 2 + (c >> 5), rr = r & 15, cc = c & 31, ob = rr * 64 + cc * 2; return st * 1024 + (ob ^ (((ob >> 9) & 1) << 5)); }
__host__ __device__ __forceinline__ void stage_rc(int b, int& R, int& C) { const int st = b / 1024, sb = b % 1024, swz = sb ^ (((sb >> 9) & 1) << 5); R = (st >> 1) * 16 + swz / 64; C = (st & 1) * 32 + (swz % 64) / 2; }
__host__ __device__ __forceinline__ int perm32(int rho) { const int n = rho >> 4, i = rho & 15; return 8 * (i >> 2) + 4 * n + (i & 3); }

struct Unit { int pm, pn; };
struct Gemm { const bf16_t* A; const bf16_t* Bt; int M, N, K; };

struct StaticOrder {
    int nM, nN, nwg, G, c;
    __host__ __device__ void init(int M, int N, int G_, int c_) { nM = M / BM; nN = N / BM; nwg = nM * nN; G = G_; c = c_; }
    __host__ __device__ bool next(int i, Unit& u) const {
        const long L = (long)i * G + c; if (L >= nwg) return false;
        int wgid = (int)L; { const int q = nwg / NXCD, r = nwg % NXCD, xcd = wgid % NXCD, off = wgid / NXCD; wgid = (xcd < r ? xcd * (q + 1) : r * (q + 1) + (xcd - r) * q) + off; }
        const int nig = WGM * nN, gid = wgid / nig, fm = gid * WGM, gsz = (nM - fm) < WGM ? (nM - fm) : WGM;
        u.pm = fm + ((wgid % nig) % gsz); u.pn = (wgid % nig) / gsz; return true;
    }
    __device__ __forceinline__ void a_ready(const Unit&) const {}
    __device__ __forceinline__ void done(const Unit&) const {}
};
template <class Epi, class Sched, bool ALIGN_EPI = false, bool SP2 = false>
__device__ __forceinline__ void gemm_phase(PG8_LAS unsigned char* lds, const Gemm g, const Sched& S, const Epi& E) {
    int tid_l = threadIdx.x; asm volatile("" : "+v"(tid_l));
    const int tid = tid_l, wid = __builtin_amdgcn_readfirstlane(tid >> 6), lane = tid & 63, wr = wid >> 2, wc = wid & 3, fr = lane & 15, fq = lane >> 4;
    const int K = g.K, nt = K / BK;
    unsigned voffA[2], voffB[2];
#pragma unroll
    for (int i = 0; i < 2; ++i) { int R, C; stage_rc(tid * 16 + i * 8192, R, C); const int Rb = Epi::PERM ? ((R & ~31) + perm32(R & 31)) : R;
        voffA[i] = (unsigned)(R * K + C) * 2u; voffB[i] = (unsigned)(Rb * K + C) * 2u; }
    const size_t kstep = (size_t)(BK * 2);
    const size_t hstep = (size_t)HALF * K * 2;
    const size_t tstep = 2 * hstep;
    const unsigned ldsw = (unsigned)wid * 1024u;
    const int aoff = lds_byte(wr * 64 + fr, fq * 8), boff = lds_byte(wc * 32 + fr, fq * 8);
#define PG8_SA(b, h) (((b) * 2 + (h)) * HTB)
#define PG8_SB(b, h) ((4 + (b) * 2 + (h)) * HTB)
#define PG8_STAGE(bufoff, gbase, voff) do { _Pragma("unroll") for (int _i = 0; _i < 2; ++_i) \
        __builtin_amdgcn_global_load_lds((const unsigned*)((const char*)(gbase) + (voff)[_i]), (PG8_LAS unsigned*)(lds + (bufoff) + ldsw + _i * 8192), 16, 0, 0); } while (0)
#define PG8_LDA(dst, b, h) do { _Pragma("unroll") for (int m = 0; m < 4; ++m) _Pragma("unroll") for (int k = 0; k < 2; ++k) dst[m][k] = *(const PG8_LAS bf16x8*)(lds + PG8_SA(b, h) + aoff + m * 2048 + k * 1024); } while (0)
#define PG8_LDB(dst, b, h) do { _Pragma("unroll") for (int n = 0; n < 2; ++n) _Pragma("unroll") for (int k = 0; k < 2; ++k) dst[n][k] = *(const PG8_LAS bf16x8*)(lds + PG8_SB(b, h) + boff + n * 2048 + k * 1024); } while (0)
#define PG8_MMA(ai, bj, At, Bt) do { __builtin_amdgcn_s_setprio(1); _Pragma("unroll") for (int m = 0; m < 4; ++m) _Pragma("unroll") for (int n = 0; n < 2; ++n) _Pragma("unroll") for (int k = 0; k < 2; ++k) \
        acc[ai][bj][m][n] = __builtin_amdgcn_mfma_f32_16x16x32_bf16(Bt[n][k], At[m][k], acc[ai][bj][m][n], 0, 0, 0); __builtin_amdgcn_s_setprio(0); } while (0)
#define PG8_WAIT_V(n) asm volatile("s_waitcnt vmcnt(" #n ")" ::: "memory")
#define PG8_WAIT_L(n) asm volatile("s_waitcnt lgkmcnt(" #n ")" ::: "memory")
#define PG8_BAR __builtin_amdgcn_s_barrier()
#define PG8_SCHED __builtin_amdgcn_sched_barrier(0)
    Unit cur, nxt; int ui = 0;
    if (!S.next(0, cur)) return;
    f32x4 acc[2][2][4][2];
#pragma unroll
    for (int a = 0; a < 2; ++a)
#pragma unroll
        for (int b = 0; b < 2; ++b)
#pragma unroll
            for (int m = 0; m < 4; ++m)
#pragma unroll
                for (int n = 0; n < 2; ++n) acc[a][b][m][n] = (f32x4){0.f, 0.f, 0.f, 0.f};
    bf16x8 At[4][2], B0[2][2], B1[2][2];
    const char* cA = (const char*)g.A + (size_t)cur.pm * tstep; const char* cB = (const char*)g.Bt + (size_t)cur.pn * tstep;
    S.a_ready(cur);
    if constexpr (SP2) {
        PG8_STAGE(PG8_SB(0, 0), cB, voffB); PG8_STAGE(PG8_SB(0, 1), cB + hstep, voffB); PG8_STAGE(PG8_SA(0, 0), cA, voffA); PG8_STAGE(PG8_SA(0, 1), cA + hstep, voffA);
        if (wr == 1) PG8_BAR;
        PG8_WAIT_V(2); PG8_BAR;
        PG8_STAGE(PG8_SB(1, 0), cB + kstep, voffB); PG8_STAGE(PG8_SA(1, 0), cA + kstep, voffA); PG8_STAGE(PG8_SB(1, 1), cB + hstep + kstep, voffB);
        PG8_WAIT_V(6); PG8_BAR;
    } else {
        PG8_STAGE(PG8_SB(0, 0), cB, voffB); PG8_STAGE(PG8_SA(0, 0), cA, voffA); PG8_STAGE(PG8_SB(0, 1), cB + hstep, voffB); PG8_STAGE(PG8_SA(0, 1), cA + hstep, voffA);
        if (wr == 1) PG8_BAR;
        PG8_WAIT_V(4); PG8_BAR;
        PG8_STAGE(PG8_SB(1, 0), cB + kstep, voffB); PG8_STAGE(PG8_SA(1, 0), cA + kstep, voffA); PG8_STAGE(PG8_SB(1, 1), cB + hstep + kstep, voffB);
        PG8_WAIT_V(6); PG8_BAR;
    }
    for (;;) {
        const bool has_next = S.next(ui + 1, nxt);
        const char* nA = has_next ? (const char*)g.A + (size_t)nxt.pm * tstep : cA; const char* nB = has_next ? (const char*)g.Bt + (size_t)nxt.pn * tstep : cB;
        for (int t = 0; t < nt; t += 2) {
            const bool last = (t == nt - 2);
            const char* a1 = cA + (size_t)(t + 1) * kstep;
            const char* a2 = last ? nA : cA + (size_t)(t + 2) * kstep; const char* b2 = last ? nB : cB + (size_t)(t + 2) * kstep;
            const char* a3 = a2 + kstep; const char* b3 = b2 + kstep;
            if (last && has_next) S.a_ready(nxt);
            if constexpr (SP2) {
            PG8_LDB(B0, 0, 0); PG8_LDB(B1, 0, 1); PG8_SCHED; PG8_LDA(At, 0, 0); PG8_STAGE(PG8_SA(1, 1), a1 + hstep, voffA);
            PG8_WAIT_V(8); PG8_WAIT_L(0); PG8_BAR; PG8_MMA(0, 0, At, B0); PG8_MMA(0, 1, At, B1); PG8_BAR; PG8_SCHED;
            PG8_LDA(At, 0, 1); PG8_STAGE(PG8_SB(0, 0), b2, voffB); PG8_STAGE(PG8_SB(0, 1), b2 + hstep, voffB); PG8_STAGE(PG8_SA(0, 0), a2, voffA);
            PG8_WAIT_V(8); PG8_WAIT_L(0); PG8_BAR; PG8_MMA(1, 0, At, B0); PG8_MMA(1, 1, At, B1); PG8_BAR; PG8_SCHED;
            PG8_LDB(B0, 1, 0); PG8_LDB(B1, 1, 1); PG8_SCHED; PG8_LDA(At, 1, 0); PG8_STAGE(PG8_SA(0, 1), a2 + hstep, voffA);
            PG8_WAIT_V(8); PG8_WAIT_L(0); PG8_BAR; PG8_MMA(0, 0, At, B0); PG8_MMA(0, 1, At, B1); PG8_BAR; PG8_SCHED;
            PG8_LDA(At, 1, 1); PG8_STAGE(PG8_SB(1, 0), b3, voffB); PG8_STAGE(PG8_SB(1, 1), b3 + hstep, voffB); PG8_STAGE(PG8_SA(1, 0), a3, voffA);
            PG8_WAIT_V(8); PG8_WAIT_L(0); PG8_BAR; PG8_MMA(1, 0, At, B0); PG8_MMA(1, 1, At, B1); PG8_BAR; PG8_SCHED;
            } else {
            PG8_LDB(B0, 0, 0); PG8_SCHED; PG8_LDA(At, 0, 0); PG8_STAGE(PG8_SA(1, 1), a1 + hstep, voffA);
            PG8_WAIT_L(8); PG8_BAR; PG8_WAIT_L(0); PG8_MMA(0, 0, At, B0); PG8_BAR; PG8_SCHED;
            PG8_LDB(B1, 0, 1); PG8_STAGE(PG8_SB(0, 0), b2, voffB);
            PG8_BAR; PG8_WAIT_L(0); PG8_MMA(0, 1, At, B1); PG8_BAR;
            PG8_LDA(At, 0, 1); PG8_STAGE(PG8_SA(0, 0), a2, voffA);
            PG8_BAR; PG8_WAIT_L(0); PG8_MMA(1, 0, At, B0); PG8_BAR; PG8_SCHED;
            PG8_STAGE(PG8_SB(0, 1), b2 + hstep, voffB);
            PG8_WAIT_V(6); PG8_BAR; PG8_MMA(1, 1, At, B1); PG8_BAR;
            PG8_LDB(B0, 1, 0); PG8_SCHED; PG8_LDA(At, 1, 0); PG8_STAGE(PG8_SA(0, 1), a2 + hstep, voffA);
            PG8_WAIT_L(8); PG8_BAR; PG8_WAIT_L(0); PG8_MMA(0, 0, At, B0); PG8_BAR; PG8_SCHED;
            PG8_LDB(B1, 1, 1); PG8_STAGE(PG8_SB(1, 0), b3, voffB);
            PG8_BAR; PG8_WAIT_L(0); PG8_MMA(0, 1, At, B1); PG8_BAR;
            PG8_LDA(At, 1, 1); PG8_STAGE(PG8_SA(1, 0), a3, voffA);
            PG8_BAR; PG8_WAIT_L(0); PG8_MMA(1, 0, At, B0); PG8_BAR; PG8_SCHED;
            PG8_STAGE(PG8_SB(1, 1), b3 + hstep, voffB);
            PG8_WAIT_V(6); PG8_BAR; PG8_MMA(1, 1, At, B1); PG8_BAR;
            }
        }
        if constexpr (ALIGN_EPI) { if (wr == 0) PG8_BAR; }
        bool zero_acc = true;
        if constexpr (!Epi::AFTER_DRAIN) { zero_acc = E(acc, cur, wr, wc, fr, fq); S.done(cur); }
        if (!has_next) break;
        if (zero_acc) {
#pragma unroll
        for (int a = 0; a < 2; ++a)
#pragma unroll
            for (int b = 0; b < 2; ++b)
#pragma unroll
                for (int m = 0; m < 4; ++m)
#pragma unroll
                    for (int n = 0; n < 2; ++n) acc[a][b][m][n] = (f32x4){0.f, 0.f, 0.f, 0.f};
        }
        cur = nxt; cA = nA; cB = nB; ++ui;
        if constexpr (ALIGN_EPI) { if (wr == 1) PG8_BAR; }
    }
    PG8_WAIT_V(0);
    if constexpr (!ALIGN_EPI) { if (wr == 0) PG8_BAR; }
    PG8_BAR;
    if constexpr (Epi::AFTER_DRAIN) { E.fused(acc, cur, wr, wc, fr, fq, lds, wid, lane); S.done(cur); }
#undef PG8_SA
#undef PG8_SB
#undef PG8_STAGE
#undef PG8_LDA
#undef PG8_LDB
#undef PG8_MMA
#undef PG8_WAIT_V
#undef PG8_WAIT_L
#undef PG8_BAR
#undef PG8_SCHED
}
}

typedef unsigned short bf16_t;
typedef short bf16x8 __attribute__((ext_vector_type(8)));
typedef float f32x16 __attribute__((ext_vector_type(16)));
typedef float f32x4 __attribute__((ext_vector_type(4)));
typedef float f32x2 __attribute__((ext_vector_type(2)));
typedef __bf16 bf16x2_t __attribute__((ext_vector_type(2)));
typedef unsigned u32x4 __attribute__((ext_vector_type(4)));
typedef unsigned u32x2 __attribute__((ext_vector_type(2)));

#define DI __device__ __forceinline__
#define MFMA32(a, b, c) __builtin_amdgcn_mfma_f32_32x32x16_bf16((a), (b), (c), 0, 0, 0)

constexpr int T_ = 16384, S_ = 2048, DM = 1024, NP = 8960, DEPTH = 4, NT = 512;
constexpr int AQ = 0, AK = 256, AV = 512, AG = 1024, BQ = 1536, BKc = 2048, BV = 2560, BG = 3072, CQ = 3584, CK = 4096, CV = 4608, CG = 5120, MG = 5632, LF = 8704;
constexpr int LDS_BYTES = 147456, ITEM_OFF = LDS_BYTES - 16, GLA_HALF = 63488;
constexpr float EPS = 1e-6f, LOG2E = 1.4426950408889634f;

constexpr size_t OFF_WI = 0, OFF_WB = OFF_WI + (size_t)4 * NP * 1024 * 2, OFF_WO = OFF_WB + (size_t)12 * 1024 * 512 * 2, OFF_P = OFF_WO + (size_t)4 * 1024 * 1024 * 2,
                 OFF_XB = OFF_P + (size_t)T_ * NP * 2, OFF_Y = OFF_XB + (size_t)T_ * DM * 2, OFF_MIX = OFF_Y + (size_t)3 * T_ * 512 * 2, OFF_UT = OFF_MIX + (size_t)T_ * DM * 2,
                 OFF_QH = OFF_UT + (size_t)2 * 1024 * 8192 * 2, OFF_DEC = OFF_QH + (size_t)2 * 1024 * 4096 * 2, OFF_SS = OFF_DEC + (size_t)2 * 1024 * 64 * 4,
                 OFF_SCAL = OFF_SS + (size_t)5 * T_ * 16 * 4, OFF_CNT = OFF_SCAL + 256, OFF_LSE = OFF_CNT + 256, OFF_BAR = OFF_LSE + (size_t)2 * T_ * 8 * 4, WS_END = OFF_BAR + 16384;
struct Params {
  const float *x, *norm_g, *w_in, *gate_up, *gate_b, *gla_norm_g, *diff_lambda, *diff_norm_g, *w_branch, *w_out, *final_g;
  float* out; char* ws;
  __device__ __forceinline__ bf16_t* Wi_() const { return (bf16_t*)(ws + OFF_WI); }
  __device__ __forceinline__ bf16_t* Wb_() const { return (bf16_t*)(ws + OFF_WB); }
  __device__ __forceinline__ bf16_t* Wo_() const { return (bf16_t*)(ws + OFF_WO); }
  __device__ __forceinline__ bf16_t* P_() const { return (bf16_t*)(ws + OFF_P); }
  __device__ __forceinline__ bf16_t* XB_() const { return (bf16_t*)(ws + OFF_XB); }
  __device__ __forceinline__ bf16_t* Y_() const { return (bf16_t*)(ws + OFF_Y); }
  __device__ __forceinline__ bf16_t* MIX_() const { return (bf16_t*)(ws + OFF_MIX); }
  __device__ __forceinline__ float* OA_() const { return (float*)(ws + OFF_MIX); }
  __device__ __forceinline__ bf16_t* UT_() const { return (bf16_t*)(ws + OFF_UT); }
  __device__ __forceinline__ bf16_t* QH_() const { return (bf16_t*)(ws + OFF_QH); }
  __device__ __forceinline__ float* DEC_() const { return (float*)(ws + OFF_DEC); }
  __device__ __forceinline__ float* SS_() const { return (float*)(ws + OFF_SS); }
  __device__ __forceinline__ float* scal_() const { return (float*)(ws + OFF_SCAL); }
  __device__ __forceinline__ int* cnt_() const { return (int*)(ws + OFF_CNT); }
  __device__ __forceinline__ float* LSE_() const { return (float*)(ws + OFF_LSE); }
};

DI unsigned pk2(float lo, float hi) { f32x2 v = {lo, hi}; bf16x2_t b = __builtin_convertvector(v, bf16x2_t); return __builtin_bit_cast(unsigned, b); }
DI float bflo(unsigned u) { return __uint_as_float(u << 16); }
DI float bfhi(unsigned u) { return __uint_as_float(u & 0xffff0000u); }
DI float bf2f(bf16_t h) { return __uint_as_float(((unsigned)h) << 16); }
DI int crow(int reg, int hh) { return (reg & 3) + 8 * (reg >> 2) + 4 * hh; }
DI float ex2(float x) { return __builtin_amdgcn_exp2f(x); }
DI float siluf(float x) { return x * __builtin_amdgcn_rcpf(1.f + __expf(-x)); }
DI float sigmf(float x) { return __builtin_amdgcn_rcpf(1.f + __expf(-x)); }
DI float logsig(float z) { return fminf(z, 0.f) - __logf(1.f + __expf(-fabsf(z))); }
DI bf16x8 pack_step(const f32x16& x, int s) {
  u32x4 p;
  p[0] = pk2(x[8 * s + 0], x[8 * s + 1]); p[1] = pk2(x[8 * s + 2], x[8 * s + 3]);
  p[2] = pk2(x[8 * s + 4], x[8 * s + 5]); p[3] = pk2(x[8 * s + 6], x[8 * s + 7]);
  return __builtin_bit_cast(bf16x8, p);
}
DI bf16x8 cat2(u32x2 lo, u32x2 hi) { u32x4 v = {lo[0], lo[1], hi[0], hi[1]}; return __builtin_bit_cast(bf16x8, v); }
DI void tr4x8(const u32x4& r0, const u32x4& r1, const u32x4& r2, const u32x4& r3, u32x2 (&o)[8]) {
#pragma unroll
  for (int wd = 0; wd < 4; ++wd) {
    const unsigned a = r0[wd], b = r1[wd], c = r2[wd], d = r3[wd];
    o[2 * wd][0] = (a & 0xffffu) | (b << 16); o[2 * wd][1] = (c & 0xffffu) | (d << 16);
    o[2 * wd + 1][0] = (a >> 16) | (b & 0xffff0000u); o[2 * wd + 1][1] = (c >> 16) | (d & 0xffff0000u);
  }
}
#define LDS_BARRIER() do { asm volatile("s_waitcnt lgkmcnt(0)" ::: "memory"); __builtin_amdgcn_s_barrier(); asm volatile("" ::: "memory"); } while (0)
DI f32x16 zero16() { f32x16 z; for (int i = 0; i < 16; ++i) z[i] = 0.f; return z; }
DI float row_rs(const float* __restrict__ SSl, int t) {
  const f32x4 a = *(const f32x4*)(SSl + (size_t)t * 16), b = *(const f32x4*)(SSl + (size_t)t * 16 + 4);
  const f32x4 c = *(const f32x4*)(SSl + (size_t)t * 16 + 8), d = *(const f32x4*)(SSl + (size_t)t * 16 + 12);
  const float ss = (((a[0] + a[1]) + (a[2] + a[3])) + ((b[0] + b[1]) + (b[2] + b[3]))) + (((c[0] + c[1]) + (c[2] + c[3])) + ((d[0] + d[1]) + (d[2] + d[3])));
  return rsqrtf(ss * (1.f / 1024.f) + EPS);
}
DI int win_col(int n) {
  const bool rope = (n >= BQ && n < BV) || (n >= CQ && n < CV);
  if (rope) { const int p = n & 63; n = (n & ~63) + 32 * ((p >> 2) & 1) + 16 * (p >> 5) + 4 * ((p >> 3) & 3) + (p & 3); }
  if (n < 1536) return n;
  if (n < LF) return n + 32;
  if (n < LF + 32) return n - LF + 1536;
  return -1;
}
DI float win_scale(int n) {
  if (n < AK) return 0.125f;
  if ((n >= BQ && n < BKc) || (n >= CQ && n < CK)) return 0.125f * LOG2E;
  return 1.f;
}

extern __shared__ __attribute__((aligned(16))) char g_lds[];
struct EpiInproj {
  static constexpr bool PERM = true, AFTER_DRAIN = false;
  bf16_t* P;
  DI bool operator()(pg8::f32x4 (&acc)[2][2][4][2], const pg8::Unit& u, int wr, int wc, int fr, int fq) const {
    const int colt = u.pn * 256;
    const PG8_LAS unsigned char* l3 = (const PG8_LAS unsigned char*)g_lds;
    const PG8_LAS int* ulist = (const PG8_LAS int*)(l3 + 131072 + 14336);
    const int key = (u.pm << 8) | u.pn; int slot = 0;
#pragma unroll
    for (int i = 1; i < 14; ++i) slot = ulist[i] == key ? i : slot;
    const PG8_LAS float* rsrow = (const PG8_LAS float*)(l3 + 131072) + slot * 256;
    const bool rope = (colt >= BQ && colt < BV) || (colt >= CQ && colt < CV);
    const bool gate = colt >= MG && colt < LF;
#pragma unroll
    for (int ai = 0; ai < 2; ++ai)
#pragma unroll
      for (int m = 0; m < 4; ++m) {
        const int row = u.pm * 256 + ai * 128 + wr * 64 + m * 16 + fr;
        const float rs = rsrow[ai * 128 + wr * 64 + m * 16 + fr];
        bf16_t* rowp = P + (size_t)row * NP;
#pragma unroll
        for (int bj = 0; bj < 2; ++bj) {
          const f32x4 v0 = acc[ai][bj][m][0] * rs, v1 = acc[ai][bj][m][1] * rs;
          if (gate) {
            float q[8];
#pragma unroll
            for (int j = 0; j < 4; ++j) { q[j] = 1.f + __expf(fminf(-v0[j], 80.f)); q[4 + j] = 1.f + __expf(fminf(-v1[j], 80.f)); }
            u32x4 o = {pk2(q[0], q[1]), pk2(q[2], q[3]), pk2(q[4], q[5]), pk2(q[6], q[7])};
            *(u32x4*)(rowp + colt + bj * 128 + wc * 32 + 8 * fq) = o;
          } else if (!rope) {
            u32x4 o = {pk2(v0[0], v0[1]), pk2(v0[2], v0[3]), pk2(v1[0], v1[1]), pk2(v1[2], v1[3])};
            *(u32x4*)(rowp + colt + bj * 128 + wc * 32 + 8 * fq) = o;
          } else {
            const int d0 = 16 * (wc & 1) + 4 * fq;
            const float pos = (float)(row & (S_ - 1));
            float y1[4], y2[4];
#pragma unroll
            for (int j = 0; j < 4; ++j) {
              const float inv = ex2(-(float)(d0 + j) * 0.41524101186f);
              float rev = (pos * inv) * 0.15915494309189535f;
              rev -= floorf(rev);
              const float sn = __builtin_amdgcn_sinf(rev), cs = __builtin_amdgcn_cosf(rev);
              y1[j] = v0[j] * cs - v1[j] * sn; y2[j] = v1[j] * cs + v0[j] * sn;
            }
            bf16_t* hp = rowp + colt + bj * 128 + (wc >> 1) * 64 + d0;
            u32x2 o1 = {pk2(y1[0], y1[1]), pk2(y1[2], y1[3])}, o2 = {pk2(y2[0], y2[1]), pk2(y2[2], y2[3])};
            *(u32x2*)hp = o1; *(u32x2*)(hp + 32) = o2;
          }
        }
      }
    return true;
  }
};
struct EpiNullProbe {
  static constexpr bool PERM = true, AFTER_DRAIN = false;
  float* sink; const float* flag; const float* SSp;
  DI bool operator()(pg8::f32x4 (&acc)[2][2][4][2], const pg8::Unit& u, int wr, int wc, int fr, int fq) const {
    float rsum = 0.f;
#pragma unroll
    for (int ai = 0; ai < 2; ++ai)
#pragma unroll
      for (int m = 0; m < 4; ++m) rsum += row_rs(SSp, u.pm * 256 + ai * 128 + wr * 64 + m * 16 + fr);
    if (rsum == 12345.678f) {
      float s = 0.f;
#pragma unroll
      for (int ai = 0; ai < 2; ++ai)
#pragma unroll
        for (int bj = 0; bj < 2; ++bj)
#pragma unroll
          for (int m = 0; m < 4; ++m) s += acc[ai][bj][m][0][0] + acc[ai][bj][m][1][3] + acc[ai][bj][m][0][2] + acc[ai][bj][m][1][1];
      sink[u.pm * 64 + fr] = s;
    }
    return true;
  }
};
struct EpiMerge {
  static constexpr bool PERM = true, AFTER_DRAIN = false;
  const bf16_t* P; bf16_t* MIX;
  DI bool operator()(pg8::f32x4 (&acc)[2][2][4][2], const pg8::Unit& u, int wr, int wc, int fr, int fq) const {
    const int g = u.pn >> 2, colt = (u.pn & 3) * 256, rowt = (u.pm & 63) * 256;
#pragma unroll
    for (int ai = 0; ai < 2; ++ai)
#pragma unroll
      for (int m = 0; m < 4; ++m) {
        const int row = rowt + ai * 128 + wr * 64 + m * 16 + fr;
#pragma unroll
        for (int bj = 0; bj < 2; ++bj) {
          const int col0 = colt + bj * 128 + wc * 32 + 8 * fq;
          const u32x4 ga = *(const u32x4*)(P + (size_t)row * NP + MG + g * 1024 + col0);
          float f[8] = {__builtin_amdgcn_rcpf(bflo(ga[0])), __builtin_amdgcn_rcpf(bfhi(ga[0])), __builtin_amdgcn_rcpf(bflo(ga[1])), __builtin_amdgcn_rcpf(bfhi(ga[1])),
                        __builtin_amdgcn_rcpf(bflo(ga[2])), __builtin_amdgcn_rcpf(bfhi(ga[2])), __builtin_amdgcn_rcpf(bflo(ga[3])), __builtin_amdgcn_rcpf(bfhi(ga[3]))};
          if (g < 2) {
            const u32x4 gb = *(const u32x4*)(P + (size_t)row * NP + MG + (g + 1) * 1024 + col0);
            f[0] *= bflo(gb[0]); f[1] *= bfhi(gb[0]); f[2] *= bflo(gb[1]); f[3] *= bfhi(gb[1]); f[4] *= bflo(gb[2]); f[5] *= bfhi(gb[2]); f[6] *= bflo(gb[3]); f[7] *= bfhi(gb[3]);
          }
#pragma unroll
          for (int j = 0; j < 4; ++j) { acc[ai][bj][m][0][j] *= f[j]; acc[ai][bj][m][1][j] *= f[4 + j]; }
          if (g == 2) {
            const pg8::f32x4 v0 = acc[ai][bj][m][0], v1 = acc[ai][bj][m][1];
            u32x4 o = {pk2(v0[0], v0[1]), pk2(v0[2], v0[3]), pk2(v1[0], v1[1]), pk2(v1[2], v1[3])};
            *(u32x4*)(MIX + (size_t)row * DM + col0) = o;
          }
        }
      }
    return g == 2;
  }
};
struct MergeOrder {
  int G, c;
  DI bool next(int i, pg8::Unit& u) const {
    const int tile = c + (i / 3) * G, g = i % 3;
    if (tile >= 256) return false;
    u.pm = g * 64 + (tile >> 2); u.pn = g * 4 + (tile & 3); return true;
  }
  DI void a_ready(const pg8::Unit&) const {}
  DI void done(const pg8::Unit&) const {}
};
struct EpiOut {
  static constexpr bool PERM = true, AFTER_DRAIN = false;
  const float* X0; bf16_t* XB; float* SSn;
  DI bool operator()(pg8::f32x4 (&acc)[2][2][4][2], const pg8::Unit& u, int wr, int wc, int fr, int fq) const {
    const int colt = u.pn * 256;
#pragma unroll
    for (int ai = 0; ai < 2; ++ai)
#pragma unroll
      for (int m = 0; m < 4; ++m) {
        const int row = u.pm * 256 + ai * 128 + wr * 64 + m * 16 + fr;
        float ss = 0.f;
#pragma unroll
        for (int bj = 0; bj < 2; ++bj) {
          const size_t off = (size_t)row * DM + colt + bj * 128 + wc * 32 + 8 * fq;
          pg8::f32x4 x0, x1;
          if (X0) { x0 = *(const pg8::f32x4*)(X0 + off); x1 = *(const pg8::f32x4*)(X0 + off + 4); }
          else { const u32x4 xb = *(const u32x4*)(XB + off); x0 = (pg8::f32x4){bflo(xb[0]), bfhi(xb[0]), bflo(xb[1]), bfhi(xb[1])}; x1 = (pg8::f32x4){bflo(xb[2]), bfhi(xb[2]), bflo(xb[3]), bfhi(xb[3])}; }
          x0 += acc[ai][bj][m][0]; x1 += acc[ai][bj][m][1];
          u32x4 o = {pk2(x0[0], x0[1]), pk2(x0[2], x0[3]), pk2(x1[0], x1[1]), pk2(x1[2], x1[3])};
          *(u32x4*)(XB + off) = o;
          const float r0 = bflo(o[0]), r1 = bfhi(o[0]), r2 = bflo(o[1]), r3 = bfhi(o[1]), r4 = bflo(o[2]), r5 = bfhi(o[2]), r6 = bflo(o[3]), r7 = bfhi(o[3]);
          ss += ((r0 * r0 + r1 * r1) + (r2 * r2 + r3 * r3)) + ((r4 * r4 + r5 * r5) + (r6 * r6 + r7 * r7));
        }
        ss += __shfl_xor(ss, 16); ss += __shfl_xor(ss, 32);
        if (fq == 0) SSn[(size_t)row * 16 + u.pn * 4 + wc] = ss;
      }
    return true;
  }
};

DI void conv_tile(bool active, const float* __restrict__ src, int ld, int kind, const float* __restrict__ rs, bf16_t* __restrict__ dst, int K, int n0, int k0, char* ldsh, int tid) {
  float* tl = (float*)ldsh;
  if (active) {
    const int nn = tid & 63, n = n0 + nn;
    const int col = kind == 0 ? win_col(n) : n;
    const float cs = kind == 0 ? win_scale(n) : 1.f;
    float vv[16];
#pragma unroll
    for (int i = 0; i < 16; ++i) vv[i] = col >= 0 ? src[(size_t)(k0 + (tid >> 6) + 4 * i) * ld + col] : 0.f;
#pragma unroll
    for (int i = 0; i < 16; ++i) {
      const int kk = (tid >> 6) + 4 * i;
      float v = vv[i] * cs; if (rs) v *= rs[k0 + kk];
      tl[kk * 65 + nn] = v;
    }
  }
  __syncthreads();
  if (active) {
    const int nl = tid >> 2, kq = tid & 3;
    u32x4 o0, o1;
#pragma unroll
    for (int j = 0; j < 4; ++j) {
      o0[j] = pk2(tl[(kq * 16 + 2 * j) * 65 + nl], tl[(kq * 16 + 2 * j + 1) * 65 + nl]);
      o1[j] = pk2(tl[(kq * 16 + 8 + 2 * j) * 65 + nl], tl[(kq * 16 + 8 + 2 * j + 1) * 65 + nl]);
    }
    bf16_t* dp = dst + (size_t)(n0 + nl) * K + k0 + kq * 16;
    *(u32x4*)dp = o0; *(u32x4*)(dp + 8) = o1;
  }
  __syncthreads();
}

DI void prologue(const Params& p, char* lds) {
  int tidf = threadIdx.x; asm volatile("" : "+v"(tidf)); const int lane = tidf & 63, half = tidf >> 8, tid = tidf & 255;
  constexpr int NTN = NP / 64, NT_WI = 4 * NTN * 16, NT_WB = 12 * 16 * 8, NT_WO = 4 * 16 * 16, NT_ALL = NT_WI + NT_WB + NT_WO;
  for (int base = blockIdx.x * 2; base < NT_ALL; base += gridDim.x * 2) {
    const int tile = base + half; const bool act = tile < NT_ALL;
    char* ldsh = lds + half * 16896;
    if (tile < NT_WI) {
      const int l = tile / (NTN * 16), rem = tile % (NTN * 16), nt = rem >> 4, kt = rem & 15;
      conv_tile(act, p.w_in + (size_t)l * 1024 * 8736, 8736, 0, p.norm_g + l * 1024, p.Wi_() + (size_t)l * NP * 1024, 1024, nt * 64, kt * 64, ldsh, tid);
    } else if (tile < NT_WI + NT_WB) {
      const int t2 = tile - NT_WI, mtx = t2 >> 7, rem = t2 & 127, nt = rem >> 3, kt = rem & 7;
      conv_tile(act, p.w_branch + (size_t)mtx * 512 * 1024, 1024, 1, nullptr, p.Wb_() + (size_t)mtx * 1024 * 512, 512, nt * 64, kt * 64, ldsh, tid);
    } else {
      const int t2 = (act ? tile : NT_ALL - 1) - NT_WI - NT_WB, l = t2 >> 8, rem = t2 & 255, nt = rem >> 4, kt = rem & 15;
      conv_tile(act, p.w_out + (size_t)l * 1024 * 1024, 1024, 1, nullptr, p.Wo_() + (size_t)l * 1024 * 1024, 1024, nt * 64, kt * 64, ldsh, tid);
    }
  }
  const int gw = (blockIdx.x * NT + tidf) >> 6, nw = gridDim.x * (NT / 64);
  for (int t = gw; t < T_; t += nw) {
    float ss = 0.f;
#pragma unroll
    for (int i = 0; i < 4; ++i) {
      const f32x4 v = *(const f32x4*)(p.x + (size_t)t * DM + i * 256 + lane * 4);
      ss += v[0] * v[0] + v[1] * v[1] + v[2] * v[2] + v[3] * v[3];
      u32x2 o = {pk2(v[0], v[1]), pk2(v[2], v[3])};
      *(u32x2*)(p.XB_() + (size_t)t * DM + i * 256 + lane * 4) = o;
    }
#pragma unroll
    for (int s = 32; s > 0; s >>= 1) ss += __shfl_xor(ss, s);
    if (lane < 16) p.SS_()[(size_t)t * 16 + lane] = lane == 0 ? ss : 0.f;
  }
#if SELF_POISON
  {
    const size_t gt0 = (size_t)blockIdx.x * NT + tidf, gs0 = (size_t)gridDim.x * NT;
    u32x4 nanv = {0xffffffffu, 0xffffffffu, 0xffffffffu, 0xffffffffu};
    for (size_t i = gt0; i < (size_t)T_ * NP / 8; i += gs0) ((u32x4*)p.P_())[i] = nanv;
    for (size_t i = gt0; i < (size_t)T_ * 1536 / 8; i += gs0) ((u32x4*)p.Y_())[i] = nanv;
    for (size_t i = gt0; i < (size_t)T_ * DM / 8; i += gs0) ((u32x4*)p.MIX_())[i] = nanv;
    for (size_t i = gt0; i < (size_t)T_ * DM / 4; i += gs0) ((u32x4*)p.out)[i] = nanv;
  }
#endif
  const int gt = blockIdx.x * NT + tidf;
  if (gt < 64) p.cnt_()[gt] = 0;
  if (gt < DEPTH) {
    const int l = gt; const float* dl = p.diff_lambda + l * 256;
    float s1 = 0.f, s2 = 0.f;
    for (int i = 0; i < 64; ++i) { s1 += dl[i] * dl[64 + i]; s2 += dl[128 + i] * dl[192 + i]; }
    const float li = 0.8f - 0.6f * expf(-0.3f * (float)l);
    p.scal_()[l] = expf(s1) - expf(s2) + li; p.scal_()[4 + l] = li;
  }
}

#define DIFF_STEP(KR, VR, JT, CUR) do { \
    bf16_t* KsW = Ks + (1 - (CUR)) * 17408; bf16_t* VtW = KsW + 64 * 136; \
    const bf16_t* KsC = Ks + (CUR) * 17408; const bf16_t* VtC = KsC + 64 * 136; \
    if ((JT) + 1 < 32) { \
      _Pragma("unroll") \
      for (int i = 0; i < 2; ++i) *(u32x4*)(KsW + (krow_ + 32 * i) * 136 + kc) = KR[i]; \
      _Pragma("unroll") \
      for (int wd = 0; wd < 4; ++wd) { \
        const unsigned a = VR[0][wd], c = VR[1][wd]; \
        *(unsigned*)(VtW + (ec * 8 + 2 * wd) * 68 + 2 * kg2) = (a & 0xffffu) | (c << 16); \
        *(unsigned*)(VtW + (ec * 8 + 2 * wd + 1) * 68 + 2 * kg2) = (a >> 16) | (c & 0xffff0000u); \
      } \
    } \
    if ((JT) + 3 < 32) { \
      const bf16_t* base = Pb + (size_t)(((JT) + 3) * 64) * NP; \
      _Pragma("unroll") \
      for (int i = 0; i < 2; ++i) { \
        KR[i] = *(const u32x4*)(base + (size_t)(krow_ + 32 * i) * NP + BKc + h * 128 + kc); \
        VR[i] = *(const u32x4*)(base + (size_t)(2 * kg2 + i) * NP + BV + h * 128 + ec * 8); \
      } \
    } \
    f32x16 s0, s1; \
    __builtin_amdgcn_s_setprio(1); \
    _Pragma("unroll") \
    for (int ks = 0; ks < 4; ++ks) { \
      const bf16x8 k0 = *(const bf16x8*)(KsC + r * 136 + comp * 64 + ks * 16 + hh * 8); \
      const bf16x8 k1 = *(const bf16x8*)(KsC + (32 + r) * 136 + comp * 64 + ks * 16 + hh * 8); \
      if (ks == 0) { s0 = MFMA32(k0, qf[0], negm); s1 = MFMA32(k1, qf[0], negm); } \
      else { s0 = MFMA32(k0, qf[ks], s0); s1 = MFMA32(k1, qf[ks], s1); } \
    } \
    __builtin_amdgcn_s_setprio(0); \
    float mx = s0[0]; \
    _Pragma("unroll") \
    for (int i = 0; i < 16; ++i) { mx = fmaxf(mx, s0[i]); mx = fmaxf(mx, s1[i]); } \
    mx = fmaxf(mx, __shfl_xor(mx, 32)); \
    if (__any(mx > 8.f)) { \
      const float dl = fmaxf(mx, 0.f), alpha = ex2(-dl); \
      m += dl; lsum *= alpha; \
      _Pragma("unroll") \
      for (int i = 0; i < 16; ++i) { s0[i] -= dl; s1[i] -= dl; negm[i] = -m; } \
      _Pragma("unroll") \
      for (int et = 0; et < 4; ++et) \
        _Pragma("unroll") \
        for (int i = 0; i < 16; ++i) o[et][i] *= alpha; \
    } \
    float ps = 0.f; \
    _Pragma("unroll") \
    for (int i = 0; i < 16; ++i) { s0[i] = ex2(s0[i]); s1[i] = ex2(s1[i]); ps += s0[i] + s1[i]; } \
    lsum += ps; \
    __builtin_amdgcn_s_setprio(1); \
    _Pragma("unroll") \
    for (int u = 0; u < 2; ++u) \
      _Pragma("unroll") \
      for (int s = 0; s < 2; ++s) { \
        const bf16x8 pb = u == 0 ? pack_step(s0, s) : pack_step(s1, s); \
        _Pragma("unroll") \
        for (int et = 0; et < 4; ++et) { \
          const bf16_t* vp = VtC + (et * 32 + r) * 68 + u * 32 + s * 16 + hh * 4; \
          const bf16x8 va = cat2(*(const u32x2*)vp, *(const u32x2*)(vp + 8)); \
          o[et] = MFMA32(va, pb, o[et]); \
        } \
      } \
    __builtin_amdgcn_s_setprio(0); \
    LDS_BARRIER(); \
  } while (0)
DI void diff_item(const Params& p, int l, int b, int h, int qblk, char* lds) {
  int tid = threadIdx.x; asm volatile("" : "+v"(tid)); const int lane = tid & 63, w = tid >> 6, qg = w >> 1, comp = w & 1, r = lane & 31, hh = lane >> 5;
  bf16_t* Ks = (bf16_t*)lds; bf16_t* Vt = Ks + 64 * 136;
  const bf16_t* Pb = p.P_() + (size_t)(b * S_) * NP;
  bf16x8 qf[4];
  {
    const bf16_t* qp = Pb + (size_t)(qblk * 128 + qg * 32 + r) * NP + BQ + h * 128 + comp * 64 + hh * 8;
#pragma unroll
    for (int ks = 0; ks < 4; ++ks) qf[ks] = *(const bf16x8*)(qp + ks * 16);
  }
  f32x16 o[4]; o[0] = zero16(); o[1] = zero16(); o[2] = zero16(); o[3] = zero16();
  float m = 0.f, lsum = 0.f;
  f32x16 negm = zero16();
  u32x4 krA[2], vrA[2], krB[2], vrB[2];
  const int krow_ = tid >> 4, kc = (tid & 15) * 8, kg2 = tid & 31, ec = tid >> 5;
#pragma unroll
  for (int i = 0; i < 2; ++i) {
    krA[i] = *(const u32x4*)(Pb + (size_t)(krow_ + 32 * i) * NP + BKc + h * 128 + kc);
    vrA[i] = *(const u32x4*)(Pb + (size_t)(2 * kg2 + i) * NP + BV + h * 128 + ec * 8);
    krB[i] = *(const u32x4*)(Pb + (size_t)(64 + krow_ + 32 * i) * NP + BKc + h * 128 + kc);
    vrB[i] = *(const u32x4*)(Pb + (size_t)(64 + 2 * kg2 + i) * NP + BV + h * 128 + ec * 8);
  }
#pragma unroll
  for (int i = 0; i < 2; ++i) *(u32x4*)(Ks + (krow_ + 32 * i) * 136 + kc) = krA[i];
#pragma unroll
  for (int wd = 0; wd < 4; ++wd) {
    const unsigned a = vrA[0][wd], c = vrA[1][wd];
    *(unsigned*)(Vt + (ec * 8 + 2 * wd) * 68 + 2 * kg2) = (a & 0xffffu) | (c << 16);
    *(unsigned*)(Vt + (ec * 8 + 2 * wd + 1) * 68 + 2 * kg2) = (a >> 16) | (c & 0xffff0000u);
  }
#pragma unroll
  for (int i = 0; i < 2; ++i) {
    krA[i] = *(const u32x4*)(Pb + (size_t)(128 + krow_ + 32 * i) * NP + BKc + h * 128 + kc);
    vrA[i] = *(const u32x4*)(Pb + (size_t)(128 + 2 * kg2 + i) * NP + BV + h * 128 + ec * 8);
  }
  LDS_BARRIER();
#pragma unroll 1
  for (int jt = 0; jt < 32; jt += 2) {
    DIFF_STEP(krB, vrB, jt, 0);
    DIFF_STEP(krA, vrA, jt + 1, 1);
  }
  __syncthreads();
  const float lt = lsum + __shfl_xor(lsum, 32), inv = 1.f / lt;
  const float lam = p.scal_()[l], li = p.scal_()[4 + l];
  __syncthreads();
  float* cmb = (float*)lds;
  if (comp == 1) {
    const float f = lam * inv;
#pragma unroll
    for (int et = 0; et < 4; ++et)
#pragma unroll
      for (int i = 0; i < 16; ++i) cmb[(qg * 128 + et * 32 + crow(i, hh)) * 32 + r] = o[et][i] * f;
  }
  __syncthreads();
  if (comp == 0) {
    float ss = 0.f;
#pragma unroll
    for (int et = 0; et < 4; ++et)
#pragma unroll
      for (int i = 0; i < 16; ++i) { const float v = o[et][i] * inv - cmb[(qg * 128 + et * 32 + crow(i, hh)) * 32 + r]; o[et][i] = v; ss += v * v; }
    ss += __shfl_xor(ss, 32);
    const float sc = rsqrtf(ss * (1.f / 128.f) + EPS) * (1.f - li);
    const size_t t = (size_t)b * S_ + qblk * 128 + qg * 32 + r;
#pragma unroll
    for (int et = 0; et < 4; ++et)
#pragma unroll
      for (int g4 = 0; g4 < 4; ++g4) {
        const int e = et * 32 + 8 * g4 + 4 * hh;
        const u32x2 gv = *(const u32x2*)(p.P_() + t * NP + BG + h * 128 + e);
        const f32x4 gn = *(const f32x4*)(p.diff_norm_g + l * 128 + e);
        const float y0 = o[et][4 * g4] * sc * gn[0] * siluf(bflo(gv[0])), y1 = o[et][4 * g4 + 1] * sc * gn[1] * siluf(bfhi(gv[0]));
        const float y2 = o[et][4 * g4 + 2] * sc * gn[2] * siluf(bflo(gv[1])), y3 = o[et][4 * g4 + 3] * sc * gn[3] * siluf(bfhi(gv[1]));
        u32x2 ov = {pk2(y0, y1), pk2(y2, y3)};
        *(u32x2*)(p.Y_() + ((size_t)T_ + t) * 512 + h * 128 + e) = ov;
      }
  }
}

template <int G>
DI void dil_item(const Params& p, int item, char* lds) {
  int tid = threadIdx.x; asm volatile("" : "+v"(tid)); const int lane = tid & 63, w = tid >> 6, a = lane & 31, hh = lane >> 5;
  constexpr int sh = 2 * G, D = 1 << sh, Sr = S_ >> sh, NROWS = G < 2 ? 384 : 256, VP = 388;
  const int b = item >> 6, h = (item >> 3) & 7, sub = item & 7;
  bf16_t* Ks = (bf16_t*)lds;
  bf16_t* Vt = Ks + 384 * 72;
  const bf16_t* Pb = p.P_() + (size_t)(b * S_) * NP;
  const int cls0 = G < 2 ? (sub & (D - 1)) : sub * 2;
  const int big = G < 2 ? (sub >> sh) : 0;
  const int R0 = G < 2 ? big * 256 - 64 : 0;
  const int c_w = G < 2 ? cls0 : cls0 + (w >> 2);
  const int blk = G < 2 ? big * 8 + w : (w & 3);
  const int iq = blk * 32 + a, tokl = (iq << sh) + c_w;
  bf16x8 qf[4];
  {
    const bf16_t* qp = Pb + (size_t)tokl * NP + CQ + h * 64 + hh * 8;
#pragma unroll
    for (int ks = 0; ks < 4; ++ks) qf[ks] = *(const bf16x8*)(qp + ks * 16);
  }
  {
    constexpr int NKP = NROWS * 8 / 512, NVU = (NROWS / 4 * 8 + 511) / 512;
    u32x4 kr[NKP]; u32x4 vr[NVU][4];
#pragma unroll
    for (int i = 0; i < NKP; ++i) {
      const int piece = tid + 512 * i, rl = piece >> 3, c8 = piece & 7;
      int idx = G < 2 ? R0 + rl : (rl & 127); idx = idx < 0 ? 0 : (idx >= Sr ? Sr - 1 : idx);
      const int cls = G < 2 ? cls0 : cls0 + (rl >> 7);
      kr[i] = *(const u32x4*)(Pb + (size_t)((idx << sh) + cls) * NP + CK + h * 64 + c8 * 8);
    }
#pragma unroll
    for (int j = 0; j < NVU; ++j) {
      const int wu = tid + 512 * j, rg = wu >> 3, ec = wu & 7;
      if (wu < NROWS / 4 * 8) {
#pragma unroll
        for (int i = 0; i < 4; ++i) {
          const int rl = 4 * rg + i;
          int idx = G < 2 ? R0 + rl : (rl & 127); idx = idx < 0 ? 0 : (idx >= Sr ? Sr - 1 : idx);
          const int cls = G < 2 ? cls0 : cls0 + (rl >> 7);
          vr[j][i] = *(const u32x4*)(Pb + (size_t)((idx << sh) + cls) * NP + CV + h * 64 + ec * 8);
        }
      }
    }
#pragma unroll
    for (int i = 0; i < NKP; ++i) { const int piece = tid + 512 * i; *(u32x4*)(Ks + (piece >> 3) * 72 + (piece & 7) * 8) = kr[i]; }
#pragma unroll
    for (int j = 0; j < NVU; ++j) {
      const int wu = tid + 512 * j, rg = wu >> 3, ec = wu & 7;
      if (wu < NROWS / 4 * 8) {
        u32x2 tv[8]; tr4x8(vr[j][0], vr[j][1], vr[j][2], vr[j][3], tv);
#pragma unroll
        for (int x = 0; x < 8; ++x) *(u32x2*)(Vt + (ec * 8 + x) * VP + 4 * rg) = tv[x];
      }
    }
  }
  __syncthreads();
  f32x16 o[2]; o[0] = zero16(); o[1] = zero16();
  float m = -30000.f, lsum = 0.f;
#pragma unroll 1
  for (int j = 0; j < 5; ++j) {
    const int i0 = blk * 32 - 64 + 32 * j;
    if (i0 < 0 || i0 >= Sr) continue;
    const int rl0 = G < 2 ? w * 32 + 32 * j : (w >> 2) * 128 + i0;
    f32x16 st = zero16();
#pragma unroll
    for (int ks = 0; ks < 4; ++ks) { const bf16x8 kf = *(const bf16x8*)(Ks + (rl0 + a) * 72 + ks * 16 + hh * 8); st = MFMA32(kf, qf[ks], st); }
    float mx = -1e30f;
#pragma unroll
    for (int i = 0; i < 16; ++i) {
      const int dlt = i0 + crow(i, hh) - iq;
      const bool ok = (dlt <= 64) && (dlt >= -64);
      st[i] = ok ? st[i] : -1e30f;
      mx = fmaxf(mx, st[i]);
    }
    mx = fmaxf(mx, __shfl_xor(mx, 32));
    const float mn = fmaxf(m, mx), alpha = ex2(m - mn);
    m = mn;
    float ps = 0.f;
#pragma unroll
    for (int i = 0; i < 16; ++i) { st[i] = ex2(st[i] - mn); ps += st[i]; }
    lsum = lsum * alpha + ps;
#pragma unroll
    for (int i = 0; i < 16; ++i) { o[0][i] *= alpha; o[1][i] *= alpha; }
#pragma unroll
    for (int s = 0; s < 2; ++s) {
      const bf16x8 pb = pack_step(st, s);
#pragma unroll
      for (int et = 0; et < 2; ++et) {
        const bf16_t* vp = Vt + (et * 32 + a) * VP + rl0 + s * 16 + hh * 4;
        const bf16x8 va = cat2(*(const u32x2*)vp, *(const u32x2*)(vp + 8));
        o[et] = MFMA32(va, pb, o[et]);
      }
    }
  }
  const float lt = lsum + __shfl_xor(lsum, 32), inv = 1.f / lt;
  const float lse = m + __log2f(lt);
  const size_t t = (size_t)b * S_ + tokl;
  if (G < 2) {
    bf16_t* pp = (bf16_t*)p.out + ((size_t)G * T_ + t) * 512 + h * 64;
    if (hh == 0) p.LSE_()[((size_t)G * T_ + t) * 8 + h] = lse;
#pragma unroll
    for (int et = 0; et < 2; ++et)
#pragma unroll
      for (int g4 = 0; g4 < 4; ++g4) {
        u32x2 ov = {pk2(o[et][4 * g4] * inv, o[et][4 * g4 + 1] * inv), pk2(o[et][4 * g4 + 2] * inv, o[et][4 * g4 + 3] * inv)};
        *(u32x2*)(pp + et * 32 + 8 * g4 + 4 * hh) = ov;
      }
  } else {
    const float l0 = p.LSE_()[t * 8 + h], l1 = p.LSE_()[((size_t)T_ + t) * 8 + h];
    const float mxl = fmaxf(fmaxf(l0, l1), lse);
    const float w0 = ex2(l0 - mxl), w1 = ex2(l1 - mxl), w2 = ex2(lse - mxl), rd = 1.f / (w0 + w1 + w2);
    const float f0 = w0 * rd, f1 = w1 * rd, f2 = w2 * rd * inv;
    const bf16_t* p0 = (const bf16_t*)p.out + t * 512 + h * 64;
    const bf16_t* p1 = (const bf16_t*)p.out + ((size_t)T_ + t) * 512 + h * 64;
#pragma unroll
    for (int et = 0; et < 2; ++et)
#pragma unroll
      for (int g4 = 0; g4 < 4; ++g4) {
        const int e = et * 32 + 8 * g4 + 4 * hh;
        const u32x2 a0 = *(const u32x2*)(p0 + e), a1 = *(const u32x2*)(p1 + e);
        const u32x2 gv = *(const u32x2*)(p.P_() + t * NP + CG + h * 64 + e);
        const float y0 = (o[et][4 * g4] * f2 + bflo(a0[0]) * f0 + bflo(a1[0]) * f1) * siluf(bflo(gv[0]));
        const float y1 = (o[et][4 * g4 + 1] * f2 + bfhi(a0[0]) * f0 + bfhi(a1[0]) * f1) * siluf(bfhi(gv[0]));
        const float y2 = (o[et][4 * g4 + 2] * f2 + bflo(a0[1]) * f0 + bflo(a1[1]) * f1) * siluf(bflo(gv[1]));
        const float y3 = (o[et][4 * g4 + 3] * f2 + bfhi(a0[1]) * f0 + bfhi(a1[1]) * f1) * siluf(bfhi(gv[1]));
        u32x2 ov = {pk2(y0, y1), pk2(y2, y3)};
        *(u32x2*)(p.Y_() + ((size_t)2 * T_ + t) * 512 + h * 64 + e) = ov;
      }
  }
}

DI void gla_pass1(const Params& p, int l, int it2, char* lds) {
  int tidf = threadIdx.x; asm volatile("" : "+v"(tidf));
  const int half = tidf >> 8, it = it2 * 2 + half, tid = tidf & 255, lane = tid & 63, w = tid >> 6, r = lane & 31, hh = lane >> 5;
  const int b = it >> 7, h = (it >> 5) & 3, m = it & 31;
  const size_t tok0 = (size_t)b * S_ + 64 * m;
  char* ldsh = lds + half * GLA_HALF;
  float* Bf = (float*)ldsh;
  bf16_t* Qh = (bf16_t*)(ldsh + 16640);
  bf16_t* Kh = Qh + 64 * 72;
  bf16_t* KeT = Kh + 64 * 72;
  bf16_t* Vt = KeT + 64 * 72;
  float* dec = (float*)(Vt + 128 * 68);
  float* lrs = (float*)Qh;
  const int cg_ = tid & 15, dc = (tid >> 4) & 7, ec = tid >> 4;
  const int e_w = 32 * w + r, dcol = tid & 63, cq = tid >> 6;
  u32x4 qk[4];
  {
    u32x4 vv[4];
#pragma unroll
    for (int i = 0; i < 4; ++i) {
      const size_t tok1 = tok0 + 4 * cg_ + i;
      qk[i] = *(const u32x4*)(p.P_() + tok1 * NP + (tid < 128 ? AK : AQ) + h * 64 + dc * 8);
      vv[i] = *(const u32x4*)(p.P_() + tok1 * NP + AV + h * 128 + ec * 8);
    }
    u32x2 tv[8]; tr4x8(vv[0], vv[1], vv[2], vv[3], tv);
#pragma unroll
    for (int x = 0; x < 8; ++x) *(u32x2*)(Vt + (ec * 8 + x) * 68 + 4 * cg_) = tv[x];
  }
  f32x16 o0 = zero16(), o1 = zero16();
#pragma unroll
  for (int dir = 0; dir < 2; ++dir) {
  float up[16];
#pragma unroll
  for (int i = 0; i < 16; ++i) up[i] = p.gate_up[((size_t)(l * 2 + dir) * 16 + i) * 256 + h * 64 + dcol];
  const float bias = p.gate_b[(l * 2 + dir) * 256 + h * 64 + dcol];
  {
    const int c2 = tid >> 2;
    const u32x2 lv = *(const u32x2*)(p.P_() + (tok0 + c2) * NP + LF + dir * 16 + (tid & 3) * 4);
    f32x4 lf = {bflo(lv[0]), bfhi(lv[0]), bflo(lv[1]), bfhi(lv[1])};
    *(f32x4*)(lrs + c2 * 16 + (tid & 3) * 4) = lf;
  }
  __syncthreads();
#pragma unroll 4
  for (int i = 0; i < 16; ++i) {
    const int c = cq * 16 + i;
    float z = bias;
#pragma unroll
    for (int q4 = 0; q4 < 4; ++q4) {
      const f32x4 lv = *(const f32x4*)(lrs + c * 16 + q4 * 4);
      z += lv[0] * up[4 * q4] + lv[1] * up[4 * q4 + 1] + lv[2] * up[4 * q4 + 2] + lv[3] * up[4 * q4 + 3];
    }
    Bf[c * 65 + dcol] = logsig(z) * (1.f / 16.f);
  }
  __syncthreads();
  if (tid < 64) {
    float acc = 0.f;
#pragma unroll 1
    for (int c0 = 0; c0 < 64; c0 += 8) {
      float v[8];
#pragma unroll
      for (int j = 0; j < 8; ++j) { const int c = dir ? 63 - (c0 + j) : c0 + j; v[j] = Bf[c * 65 + tid]; }
#pragma unroll
      for (int j = 0; j < 8; ++j) { const int c = dir ? 63 - (c0 + j) : c0 + j; acc += v[j]; Bf[c * 65 + tid] = acc; }
    }
  }
  __syncthreads();
  {
    const int CL = dir ? 0 : 63;
    float bl[8];
#pragma unroll
    for (int x = 0; x < 8; ++x) bl[x] = Bf[CL * 65 + dc * 8 + x];
    if (tid < 128) {
      float ke[4][8];
#pragma unroll
      for (int i = 0; i < 4; ++i) {
        const int c = 4 * cg_ + i;
        float kv[8] = {bflo(qk[i][0]), bfhi(qk[i][0]), bflo(qk[i][1]), bfhi(qk[i][1]), bflo(qk[i][2]), bfhi(qk[i][2]), bflo(qk[i][3]), bfhi(qk[i][3])};
        float kh[8];
#pragma unroll
        for (int x = 0; x < 8; ++x) { const float bb = Bf[c * 65 + dc * 8 + x]; kh[x] = kv[x] * __expf(-bb); ke[i][x] = kv[x] * __expf(bl[x] - bb); }
        u32x4 o = {pk2(kh[0], kh[1]), pk2(kh[2], kh[3]), pk2(kh[4], kh[5]), pk2(kh[6], kh[7])};
        *(u32x4*)(Kh + c * 72 + dc * 8) = o;
      }
#pragma unroll
      for (int x = 0; x < 8; ++x) {
        u32x2 o = {pk2(ke[0][x], ke[1][x]), pk2(ke[2][x], ke[3][x])};
        *(u32x2*)(KeT + (dc * 8 + x) * 72 + 4 * cg_) = o;
      }
      if (cg_ == 0) {
#pragma unroll
        for (int x = 0; x < 8; ++x) { const float dv = __expf(bl[x]); dec[dc * 8 + x] = dv; p.DEC_()[((size_t)(dir * 1024 + it)) * 64 + dc * 8 + x] = dv; }
      }
    } else {
#pragma unroll
      for (int i = 0; i < 4; ++i) {
        const int c = 4 * cg_ + i;
        float qv[8] = {bflo(qk[i][0]), bfhi(qk[i][0]), bflo(qk[i][1]), bfhi(qk[i][1]), bflo(qk[i][2]), bfhi(qk[i][2]), bflo(qk[i][3]), bfhi(qk[i][3])};
#pragma unroll
        for (int x = 0; x < 8; ++x) qv[x] *= __expf(Bf[c * 65 + dc * 8 + x]);
        u32x4 o = {pk2(qv[0], qv[1]), pk2(qv[2], qv[3]), pk2(qv[4], qv[5]), pk2(qv[6], qv[7])};
        *(u32x4*)(Qh + c * 72 + dc * 8) = o;
        *(u32x4*)(p.QH_() + ((size_t)(dir * 1024 + it) * 64 + c) * 64 + dc * 8) = o;
      }
    }
  }
  __syncthreads();
  f32x16 aD0 = zero16(), aD1 = zero16(), aX = zero16();
#pragma unroll
  for (int ks = 0; ks < 4; ++ks) {
    const bf16x8 kf0 = *(const bf16x8*)(Kh + r * 72 + ks * 16 + hh * 8), kf1 = *(const bf16x8*)(Kh + (32 + r) * 72 + ks * 16 + hh * 8);
    const bf16x8 qf0 = *(const bf16x8*)(Qh + r * 72 + ks * 16 + hh * 8), qf1 = *(const bf16x8*)(Qh + (32 + r) * 72 + ks * 16 + hh * 8);
    aD0 = MFMA32(kf0, qf0, aD0); aD1 = MFMA32(kf1, qf1, aD1);
    const bf16x8 kx = dir ? kf1 : kf0, qx = dir ? qf0 : qf1;
    aX = MFMA32(kx, qx, aX);
  }
#pragma unroll
  for (int i = 0; i < 16; ++i) { const bool keep = dir ? (crow(i, hh) >= r) : (crow(i, hh) <= r); aD0[i] = keep ? aD0[i] : 0.f; aD1[i] = keep ? aD1[i] : 0.f; }
  const bf16_t* vrow = Vt + e_w * 68;
#pragma unroll
  for (int s = 0; s < 2; ++s) {
    const bf16x8 vb0 = cat2(*(const u32x2*)(vrow + s * 16 + hh * 4), *(const u32x2*)(vrow + s * 16 + hh * 4 + 8));
    const bf16x8 vb1 = cat2(*(const u32x2*)(vrow + 32 + s * 16 + hh * 4), *(const u32x2*)(vrow + 32 + s * 16 + hh * 4 + 8));
    o0 = MFMA32(pack_step(aD0, s), vb0, o0);
    o1 = MFMA32(pack_step(aD1, s), vb1, o1);
    const bf16x8 px = pack_step(aX, s);
    if (dir == 0) o1 = MFMA32(px, vb0, o1); else o0 = MFMA32(px, vb1, o0);
  }
  f32x16 S0 = zero16(), S1 = zero16();
#pragma unroll
  for (int ks = 0; ks < 4; ++ks) {
    const bf16x8 vbn = cat2(*(const u32x2*)(vrow + ks * 16 + hh * 8), *(const u32x2*)(vrow + ks * 16 + hh * 8 + 4));
    const bf16x8 ka0 = *(const bf16x8*)(KeT + r * 72 + ks * 16 + hh * 8), ka1 = *(const bf16x8*)(KeT + (32 + r) * 72 + ks * 16 + hh * 8);
    S0 = MFMA32(ka0, vbn, S0); S1 = MFMA32(ka1, vbn, S1);
  }
  {
    bf16_t* up_ = p.UT_() + ((size_t)(dir * 1024 + it) * 128 + e_w) * 64;
#pragma unroll
    for (int g4 = 0; g4 < 4; ++g4) {
      u32x2 v0 = {pk2(S0[4 * g4], S0[4 * g4 + 1]), pk2(S0[4 * g4 + 2], S0[4 * g4 + 3])};
      u32x2 v1 = {pk2(S1[4 * g4], S1[4 * g4 + 1]), pk2(S1[4 * g4 + 2], S1[4 * g4 + 3])};
      *(u32x2*)(up_ + 8 * g4 + 4 * hh) = v0; *(u32x2*)(up_ + 32 + 8 * g4 + 4 * hh) = v1;
    }
  }
  __syncthreads();
  }
#pragma unroll
  for (int i = 0; i < 16; ++i) {
    p.OA_()[(tok0 + crow(i, hh)) * 512 + h * 128 + e_w] = o0[i];
    p.OA_()[(tok0 + 32 + crow(i, hh)) * 512 + h * 128 + e_w] = o1[i];
  }
}

DI void gla_scan(const Params& p) {
  int tid = threadIdx.x; asm volatile("" : "+v"(tid));
  for (int g = blockIdx.x * NT + tid; g < 65536; g += gridDim.x * NT) {
    const int dir = g >> 15, bh = (g >> 10) & 31, ch = g & 1023, d0 = (ch * 8) & 63;
    float st[8];
#pragma unroll
    for (int x = 0; x < 8; ++x) st[x] = 0.f;
#pragma unroll 8
    for (int step = 0; step < 32; ++step) {
      const int m = dir ? 31 - step : step, it = bh * 32 + m;
      bf16_t* ptr = p.UT_() + (size_t)(dir * 1024 + it) * 8192 + ch * 8;
      const u32x4 u = *(const u32x4*)ptr;
      const float* dp = p.DEC_() + (size_t)(dir * 1024 + it) * 64 + d0;
      const f32x4 da = *(const f32x4*)dp, db = *(const f32x4*)(dp + 4);
      u32x4 o = {pk2(st[0], st[1]), pk2(st[2], st[3]), pk2(st[4], st[5]), pk2(st[6], st[7])};
      *(u32x4*)ptr = o;
      st[0] = da[0] * st[0] + bflo(u[0]); st[1] = da[1] * st[1] + bfhi(u[0]); st[2] = da[2] * st[2] + bflo(u[1]); st[3] = da[3] * st[3] + bfhi(u[1]);
      st[4] = db[0] * st[4] + bflo(u[2]); st[5] = db[1] * st[5] + bfhi(u[2]); st[6] = db[2] * st[6] + bflo(u[3]); st[7] = db[3] * st[7] + bfhi(u[3]);
    }
  }
}

DI void gla_pass3(const Params& p, int l, int it2, char* lds) {
  int tidf = threadIdx.x; asm volatile("" : "+v"(tidf));
  const int half = tidf >> 8, tid = tidf & 255, lane = tid & 63, w = tid >> 6, r = lane & 31, hh = lane >> 5;
  const int it = it2 * 2 + half;
  const int b = it >> 7, h = (it >> 5) & 3, m = it & 31;
  const size_t tok0 = (size_t)b * S_ + 64 * m;
  float* ot = (float*)(lds + half * 34816);
  f32x16 o0, o1;
#pragma unroll
  for (int i = 0; i < 16; ++i) {
    o0[i] = p.OA_()[(tok0 + crow(i, hh)) * 512 + h * 128 + 32 * w + r];
    o1[i] = p.OA_()[(tok0 + 32 + crow(i, hh)) * 512 + h * 128 + 32 * w + r];
  }
#pragma unroll
  for (int dir = 0; dir < 2; ++dir) {
    const bf16_t* qb = p.QH_() + (size_t)(dir * 1024 + it) * 4096;
    const bf16_t* sbp = p.UT_() + ((size_t)(dir * 1024 + it) * 128 + 32 * w + r) * 64;
#pragma unroll
    for (int ks = 0; ks < 4; ++ks) {
      const bf16x8 qa0 = *(const bf16x8*)(qb + r * 64 + ks * 16 + hh * 8), qa1 = *(const bf16x8*)(qb + (32 + r) * 64 + ks * 16 + hh * 8);
      const bf16x8 sv = *(const bf16x8*)(sbp + ks * 16 + hh * 8);
      o0 = MFMA32(qa0, sv, o0); o1 = MFMA32(qa1, sv, o1);
    }
  }
#pragma unroll
  for (int i = 0; i < 16; ++i) { ot[crow(i, hh) * 132 + 32 * w + r] = o0[i]; ot[(32 + crow(i, hh)) * 132 + 32 * w + r] = o1[i]; }
  unsigned gvv[16];
#pragma unroll
  for (int k = 0; k < 16; ++k) gvv[k] = *(const unsigned*)(p.P_() + (tok0 + w * 16 + k) * NP + AG + h * 128 + 2 * lane);
  __syncthreads();
  float* ssq = ot + 64 * 132;
  {
    const int c = tid & 63, q = tid >> 6;
    float part = 0.f;
#pragma unroll
    for (int j = 0; j < 8; ++j) { const f32x4 v = *(const f32x4*)(ot + c * 132 + 32 * q + 4 * j); part += (v[0] * v[0] + v[1] * v[1]) + (v[2] * v[2] + v[3] * v[3]); }
    ssq[q * 64 + c] = part;
  }
  __syncthreads();
  const f32x2 gn = *(const f32x2*)(p.gla_norm_g + l * 128 + 2 * lane);
#pragma unroll
  for (int k = 0; k < 16; ++k) {
    const int c = w * 16 + k;
    const size_t tok = tok0 + c;
    const f32x2 v = *(const f32x2*)(ot + c * 132 + 2 * lane);
    const float ss = (ssq[c] + ssq[64 + c]) + (ssq[128 + c] + ssq[192 + c]);
    const float sc = rsqrtf(ss * (1.f / 128.f) + EPS);
    const unsigned gv = gvv[k];
    *(unsigned*)(p.Y_() + tok * 512 + h * 128 + 2 * lane) = pk2(v[0] * sc * gn[0] * siluf(bflo(gv)), v[1] * sc * gn[1] * siluf(bfhi(gv)));
  }
}

template <int ONLY> DI void phase_m1(const Params& p, int l, char* lds) {
  for (int id = blockIdx.x; id < 2048; id += gridDim.x) {
    if (id < 512) {
      const int c = id & 255, k = id >> 8, xcd = c & 7, slot = c >> 3, bh = xcd * 4 + (slot >> 3), qblk = (slot & 7) + 8 * k;
      if (ONLY == 0 || ONLY == 1) diff_item(p, l, bh >> 2, bh & 3, qblk, lds);
    }
    else if (id < 1024) { if (ONLY == 0 || ONLY == 2) gla_pass1(p, l, id - 512, lds); }
    else if (id < 1536) { if (ONLY == 0 || ONLY == 3) dil_item<0>(p, id - 1024, lds); }
    else { if (ONLY == 0 || ONLY == 3) dil_item<1>(p, id - 1536, lds); }
    __syncthreads();
  }
}
DI void phase_m3(const Params& p, int l, char* lds) {
  for (int id = blockIdx.x; id < 1024; id += gridDim.x) {
    if (id < 512) dil_item<2>(p, id, lds);
    else gla_pass3(p, l, id - 512, lds);
    __syncthreads();
  }
}

DI void phase_final(const Params& p) {
  int tid = threadIdx.x; asm volatile("" : "+v"(tid)); const int lane = tid & 63;
  const int gw = (blockIdx.x * NT + tid) >> 6, nw = gridDim.x * (NT / 64);
  const float* SSl = p.SS_() + (size_t)4 * T_ * 16;
  for (int t = gw; t < T_; t += nw) {
    const float rs = row_rs(SSl, t);
#pragma unroll
    for (int i = 0; i < 4; ++i) {
      const u32x2 xb = *(const u32x2*)(p.XB_() + (size_t)t * DM + i * 256 + lane * 4);
      const f32x4 g = *(const f32x4*)(p.final_g + i * 256 + lane * 4);
      f32x4 v = {bflo(xb[0]) * rs * g[0], bfhi(xb[0]) * rs * g[1], bflo(xb[1]) * rs * g[2], bfhi(xb[1]) * rs * g[3]};
      *(f32x4*)(p.out + (size_t)t * DM + i * 256 + lane * 4) = v;
    }
  }
}

#if DEBUG_CHECK
DI unsigned hsh(unsigned x) { x ^= x >> 16; x *= 0x7feb352du; x ^= x >> 15; x *= 0x846ca68bu; x ^= x >> 16; return x; }
DI void flag_err(const Params& p, int stage, float got, float ref, float tol) {
  const float e = fabsf(got - ref);
  atomicAdd(p.cnt_() + 16 + stage, 1);
  if (!(e <= tol * fabsf(ref) + tol)) atomicAdd(p.cnt_() + 32 + stage, 1);
}
DI void chk_weights(const Params& p) {
  const int gt = blockIdx.x * NT + threadIdx.x;
  if (gt >= 2048) return;
  const unsigned hv = hsh(gt * 3u + 1u);
  const int l = hv & 3, k = (hv >> 2) & 1023; int n = (hv >> 12) % NP;
  if (gt < 64) n = LF - 8 + gt;
  const int col = win_col(n); const float cs = win_scale(n);
  const float ref = col < 0 ? 0.f : p.w_in[((size_t)l * 1024 + k) * 8736 + col] * p.norm_g[l * 1024 + k] * cs;
  flag_err(p, 1, bf2f(p.Wi_()[((size_t)l * NP + n) * 1024 + k]), ref, 0.01f);
  const int g = hv % 3, kb = (hv >> 5) & 511, nb = (hv >> 14) & 1023;
  flag_err(p, 1, bf2f(p.Wb_()[((size_t)(l * 3 + g) * 1024 + nb) * 512 + kb]), p.w_branch[(((size_t)(l * 3 + g)) * 512 + kb) * 1024 + nb], 0.01f);
  flag_err(p, 1, bf2f(p.Wo_()[((size_t)l * 1024 + nb) * 1024 + k]), p.w_out[((size_t)l * 1024 + k) * 1024 + nb], 0.01f);
}
DI float chk_proj_raw(const Params& p, int l, int t, int n) {
  const int col = n < 1536 ? n : (n < LF ? n + 32 : (n < LF + 32 ? n - LF + 1536 : -1));
  if (col < 0) return 0.f;
  float s = 0.f;
  for (int k = 0; k < 1024; ++k) {
    const float wv = p.w_in[((size_t)l * 1024 + k) * 8736 + col] * p.norm_g[l * 1024 + k] * win_scale(n);
    s += bf2f(p.XB_()[(size_t)t * DM + k]) * bf2f((bf16_t)(pk2(wv, 0.f) & 0xffff));
  }
  return s * row_rs(p.SS_() + (size_t)l * T_ * 16, t);
}
DI void chk_inproj(const Params& p, int l) {
  const int gt = blockIdx.x * NT + threadIdx.x;
  if (gt >= 512) return;
  const unsigned hv = hsh(gt * 7u + 13u + l);
  const int t = hv & (T_ - 1); int n = (hv >> 14) % 8736;
  if (gt < 128) n = BQ + (hv >> 14) % 1024;
  else if (gt < 256) n = CQ + (hv >> 14) % 1024;
  float ref = chk_proj_raw(p, l, t, n);
  const bool rope = (n >= BQ && n < BV) || (n >= CQ && n < CV);
  if (rope) {
    const int d = n & 63, dd = d & 31;
    const float other = chk_proj_raw(p, l, t, d < 32 ? n + 32 : n - 32);
    const float ang = (float)(t & (S_ - 1)) * (1.0f / powf(10000.f, (float)(2 * dd) / 64.f));
    const float cs = cosf(ang), sn = sinf(ang);
    ref = d < 32 ? ref * cs - other * sn : ref * cs + other * sn;
  }
  flag_err(p, 2, bf2f(p.P_()[(size_t)t * NP + n]), ref, 0.03f);
}
DI void chk_gla(const Params& p, int l, char* lds) {
  if (blockIdx.x >= 16) return;
  int tid = threadIdx.x & 255; asm volatile("" : "+v"(tid));
  const unsigned hv = hsh(blockIdx.x * 11u + 5u + l);
  const int b = hv & 7, h = (hv >> 3) & 3;
  int t = (hv >> 5) & (S_ - 1);
  t = (blockIdx.x & 1) ? (t & 255) : (S_ - 1 - (t & 255));
  if (blockIdx.x < 4) t = (blockIdx.x & 1) ? 300 + (hv >> 20) % 200 : S_ - 1 - 300 - (hv >> 20) % 200;
  float* kq = (float*)lds;
  float* kk = kq; float* qq = kq + 64; float* aa = kq + 128; float* vv = kq + 192; float* red = kq + 320;
  const int e = tid & 127, dh = tid >> 7;
  float otot = 0.f;
  for (int dir = 0; dir < 2; ++dir) {
    float st[32];
#pragma unroll
    for (int i = 0; i < 32; ++i) st[i] = 0.f;
    const int nsteps = dir == 0 ? t + 1 : S_ - t;
    for (int s = 0; s < nsteps; ++s) {
      const int tau = dir == 0 ? s : S_ - 1 - s;
      const size_t tok = (size_t)b * S_ + tau;
      __syncthreads();
      if (tid < 64) {
        float z = p.gate_b[(l * 2 + dir) * 256 + h * 64 + tid];
        for (int rk = 0; rk < 16; ++rk) z += bf2f(p.P_()[tok * NP + LF + dir * 16 + rk]) * p.gate_up[((size_t)(l * 2 + dir) * 16 + rk) * 256 + h * 64 + tid];
        aa[tid] = expf(logsig(z) * (1.f / 16.f));
        kk[tid] = bf2f(p.P_()[tok * NP + AK + h * 64 + tid]);
        qq[tid] = bf2f(p.P_()[tok * NP + AQ + h * 64 + tid]);
      } else if (tid < 192) vv[tid - 64] = bf2f(p.P_()[tok * NP + AV + h * 128 + tid - 64]);
      __syncthreads();
      const float ve = vv[e];
#pragma unroll
      for (int i = 0; i < 32; ++i) st[i] = aa[dh * 32 + i] * st[i] + kk[dh * 32 + i] * ve;
    }
    float part = 0.f;
#pragma unroll
    for (int i = 0; i < 32; ++i) part += qq[dh * 32 + i] * st[i];
    otot += part;
  }
  __syncthreads();
  red[tid] = otot;
  __syncthreads();
  float oe = 0.f;
  if (tid < 128) { oe = red[tid] + red[tid + 128]; }
  __syncthreads();
  if (tid < 128) red[tid] = oe * oe;
  __syncthreads();
  if (tid == 0) { float s = 0.f; for (int i = 0; i < 128; ++i) s += red[i]; red[200] = s; }
  __syncthreads();
  if (tid < 128) {
    const size_t tok = (size_t)b * S_ + t;
    const float sc = rsqrtf(red[200] * (1.f / 128.f) + EPS);
    const float ref = oe * sc * p.gla_norm_g[l * 128 + tid] * siluf(bf2f(p.P_()[tok * NP + AG + h * 128 + tid]));
    flag_err(p, 3, bf2f(p.Y_()[tok * 512 + h * 128 + tid]), ref, 0.05f);
    { const float got = bf2f(p.Y_()[tok * 512 + h * 128 + tid]);
      if (!(fabsf(got - ref) <= 0.05f * fabsf(ref) + 0.05f)) atomicOr(p.cnt_() + 50, (1 << ((t >> 6) & 1)) | (4 << (blockIdx.x & 1))); }
  }
  __syncthreads();
}
DI void chk_diff(const Params& p, int l, char* lds) {
  if (blockIdx.x < 16 || blockIdx.x >= 48) return;
  int tid = threadIdx.x < 256 ? (int)threadIdx.x : 1000000; asm volatile("" : "+v"(tid));
  const bool act = tid < 256;
  const unsigned hv = hsh(blockIdx.x * 17u + 3u + l);
  const int b = hv & 7, h = (hv >> 3) & 3, q = (hv >> 5) & (S_ - 1);
  float* w0 = (float*)lds; float* w1 = w0 + 2048; float* red = w1 + 2048;
  const size_t tq = (size_t)b * S_ + q;
  float mx0 = -1e30f, mx1 = -1e30f;
  for (int k = tid; k < S_; k += 256) {
    const size_t tk = (size_t)b * S_ + k;
    float s0 = 0.f, s1 = 0.f;
    for (int d = 0; d < 64; ++d) {
      s0 += bf2f(p.P_()[tq * NP + BQ + h * 128 + d]) * bf2f(p.P_()[tk * NP + BKc + h * 128 + d]);
      s1 += bf2f(p.P_()[tq * NP + BQ + h * 128 + 64 + d]) * bf2f(p.P_()[tk * NP + BKc + h * 128 + 64 + d]);
    }
    w0[k] = s0; w1[k] = s1; mx0 = fmaxf(mx0, s0); mx1 = fmaxf(mx1, s1);
  }
  if (act) { red[tid] = mx0; red[256 + tid] = mx1; }
  __syncthreads();
  if (tid == 0) { float a = -1e30f, c = -1e30f; for (int i = 0; i < 256; ++i) { a = fmaxf(a, red[i]); c = fmaxf(c, red[256 + i]); } red[512] = a; red[513] = c; }
  __syncthreads();
  mx0 = red[512]; mx1 = red[513];
  float l0 = 0.f, l1 = 0.f;
  for (int k = tid; k < S_; k += 256) { const float a = exp2f(w0[k] - mx0), c = exp2f(w1[k] - mx1); w0[k] = a; w1[k] = c; l0 += a; l1 += c; }
  __syncthreads();
  if (act) { red[tid] = l0; red[256 + tid] = l1; }
  __syncthreads();
  if (tid == 0) { float a = 0.f, c = 0.f; for (int i = 0; i < 256; ++i) { a += red[i]; c += red[256 + i]; } red[514] = a; red[515] = c; }
  __syncthreads();
  l0 = red[514]; l1 = red[515];
  const float lam = p.scal_()[l], li = p.scal_()[4 + l];
  float oe = 0.f;
  if (tid < 128) {
    float a0 = 0.f, a1 = 0.f;
    for (int k = 0; k < S_; ++k) { const float v = bf2f(p.P_()[((size_t)b * S_ + k) * NP + BV + h * 128 + tid]); a0 += w0[k] * v; a1 += w1[k] * v; }
    oe = a0 / l0 - lam * a1 / l1;
  }
  __syncthreads();
  if (tid < 128) red[tid] = oe * oe;
  __syncthreads();
  if (tid == 0) { float s = 0.f; for (int i = 0; i < 128; ++i) s += red[i]; red[600] = s; }
  __syncthreads();
  if (tid < 128) {
    const float sc = rsqrtf(red[600] * (1.f / 128.f) + EPS) * (1.f - li);
    const float ref = oe * sc * p.diff_norm_g[l * 128 + tid] * siluf(bf2f(p.P_()[tq * NP + BG + h * 128 + tid]));
    flag_err(p, 4, bf2f(p.Y_()[((size_t)T_ + tq) * 512 + h * 128 + tid]), ref, 0.05f);
  }
  __syncthreads();
}
DI void chk_dil(const Params& p, int l) {
  const int gt = blockIdx.x * NT + threadIdx.x - 48 * NT;
  if (gt < 0 || gt >= 512) return;
  const unsigned hv = hsh(gt * 29u + 7u + l);
  const int b = hv & 7, h = (hv >> 3) & 7, e = (hv >> 6) & 63; int t = (hv >> 12) & (S_ - 1);
  if (gt < 64) t = gt & 1 ? (t & 127) : S_ - 1 - (t & 127);
  const size_t tq = (size_t)b * S_ + t;
  float num = 0.f, den = 0.f, mx = -1e30f;
  for (int pass = 0; pass < 2; ++pass)
    for (int g = 0; g < 3; ++g) {
      const int D = 1 << (2 * g);
      for (int j = -64; j <= 64; ++j) {
        const int tk = t + j * D;
        if (tk < 0 || tk >= S_) continue;
        const size_t tkk = (size_t)b * S_ + tk;
        float s = 0.f;
        for (int d = 0; d < 64; ++d) s += bf2f(p.P_()[tq * NP + CQ + h * 64 + d]) * bf2f(p.P_()[tkk * NP + CK + h * 64 + d]);
        if (pass == 0) mx = fmaxf(mx, s);
        else { const float w = exp2f(s - mx); den += w; num += w * bf2f(p.P_()[tkk * NP + CV + h * 64 + e]); }
      }
    }
  const float ref = num / den * siluf(bf2f(p.P_()[tq * NP + CG + h * 64 + e]));
  flag_err(p, 5, bf2f(p.Y_()[((size_t)2 * T_ + tq) * 512 + h * 64 + e]), ref, 0.05f);
}
DI void chk_merge(const Params& p, int l) {
  const int gt = blockIdx.x * NT + threadIdx.x;
  if (gt >= 512) return;
  const unsigned hv = hsh(gt * 31u + 9u + l);
  const int t = hv & (T_ - 1), n = (hv >> 14) & 1023;
  float ref = 0.f;
  for (int g = 0; g < 3; ++g) {
    float s = 0.f;
    for (int k = 0; k < 512; ++k) s += bf2f(p.Y_()[((size_t)g * T_ + t) * 512 + k]) * bf2f(p.Wb_()[((size_t)(l * 3 + g) * 1024 + n) * 512 + k]);
    ref += s / bf2f(p.P_()[(size_t)t * NP + MG + g * 1024 + n]);
  }
  flag_err(p, 6, bf2f(p.MIX_()[(size_t)t * DM + n]), ref, 0.03f);
}
DI void chk_out(const Params& p, int l, const float* Xold, const float* Xnew) {
  const int gt = blockIdx.x * NT + threadIdx.x;
  if (gt >= 512) return;
  const unsigned hv = hsh(gt * 37u + 11u + l);
  const int t = hv & (T_ - 1), n = (hv >> 14) & 1023;
  float s = 0.f;
  for (int k = 0; k < 1024; ++k) s += bf2f(p.MIX_()[(size_t)t * DM + k]) * bf2f(p.Wo_()[((size_t)l * 1024 + n) * 1024 + k]);
  flag_err(p, 7, Xnew[(size_t)t * DM + n], Xold[(size_t)t * DM + n] + s, 0.01f);
  if (gt < 64) {
    float ss = 0.f;
    for (int k = 0; k < 1024; ++k) { const float v = Xnew[(size_t)t * DM + k]; ss += v * v; }
    { const float* q = p.SS_() + ((size_t)(l + 1) * T_ + t) * 16; float tot = 0.f; for (int j = 0; j < 16; ++j) tot += q[j]; flag_err(p, 8, tot, ss, 0.001f); }
  }
}
#endif

#define GSYNC() do { asm volatile("s_waitcnt vmcnt(0) lgkmcnt(0)" ::: "memory"); grid.sync(); __builtin_amdgcn_fence(__ATOMIC_ACQUIRE, "agent"); asm volatile("s_waitcnt vmcnt(0)" ::: "memory"); __syncthreads(); } while (0)
#define XB_TMO      128
#define XB_XCNT(j)  (256  + 64 * (j))
#define XB_XSUB(j)  (1280 + 64 * (j))
#define XB_XGEN(j)  (2304 + 64 * (j))
#define XB_TOP      3328
#define XB_TOPGEN   3392
#define XCD_BAR_WORDS 3456
#define XB_SPIN_CAP (1u << 18)

__device__ __forceinline__ unsigned xb_ld(unsigned* p)              { return __hip_atomic_load(p, __ATOMIC_RELAXED, __HIP_MEMORY_SCOPE_AGENT); }
__device__ __forceinline__ unsigned xb_add(unsigned* p, unsigned v) { return __hip_atomic_fetch_add(p, v, __ATOMIC_RELAXED, __HIP_MEMORY_SCOPE_AGENT); }
__device__ __forceinline__ unsigned xb_xcc_id() { return (unsigned)__builtin_amdgcn_s_getreg((3 << 11) | 20) & 0xFu; }
#define XB_SPIN(cond, bar) do { unsigned _sp = 0; while (cond) { __builtin_amdgcn_s_sleep(1); \
    if ((++_sp & 255u) == 0u) { if (xb_ld(&(bar)[XB_TMO])) break; if (_sp > XB_SPIN_CAP) { atomicAdd(&(bar)[XB_TMO], 1u); break; } } } } while (0)

struct XcdBarrier {
    unsigned* bar; unsigned x;
    volatile PG8_LAS unsigned* st;
};

__device__ __forceinline__ XcdBarrier xcd_barrier_post(unsigned* bar, volatile PG8_LAS unsigned* st) {
    XcdBarrier b; b.bar = bar; b.x = xb_xcc_id(); b.st = st;
    if (threadIdx.x == 0) (void)xb_add(&bar[XB_XCNT(b.x)], 1u);
    return b;
}
__device__ __forceinline__ void xcd_barrier_complete(unsigned* bar, unsigned x, unsigned& nloc, unsigned& nx) {
    const unsigned G = gridDim.x * gridDim.y * gridDim.z;
    unsigned sum, cnt, mine, sp = 0u;
    for (;;) {
        sum = 0u; cnt = 0u; mine = 0u;
#pragma unroll
        for (unsigned j = 0; j < 16; ++j) { const unsigned c = xb_ld(&bar[XB_XCNT(j)]); sum += c; cnt += (c > 0u) ? 1u : 0u; mine = (j == x) ? c : mine; }
        if (sum == G) break;
        __builtin_amdgcn_s_sleep(1);
        if ((++sp & 255u) == 0u) { if (xb_ld(&bar[XB_TMO])) break; if (sp > XB_SPIN_CAP) { atomicAdd(&bar[XB_TMO], 1u); break; } }
    }
    nloc = mine > 0u ? mine : 1u; nx = cnt > 0u ? cnt : 1u;
}

__device__ __forceinline__ void xcd_barrier(const XcdBarrier& b) {
    asm volatile("s_waitcnt vmcnt(0)" ::: "memory");
    __syncthreads();
    if (threadIdx.x == 0) {
        unsigned* bar = b.bar;
        __builtin_amdgcn_s_waitcnt(0);
        unsigned nloc = b.st[0], nx = b.st[1];
        if (nloc == 0u) { xcd_barrier_complete(bar, b.x, nloc, nx); b.st[0] = nloc; b.st[1] = nx; }
        const unsigned old = xb_add(&bar[XB_XSUB(b.x)], 1u);
        const unsigned gen = old / nloc;
        if (old + 1u == (gen + 1u) * nloc) {
            __builtin_amdgcn_fence(__ATOMIC_RELEASE, "agent");
            asm volatile("s_waitcnt vmcnt(0)" ::: "memory");
            const unsigned og = xb_add(&bar[XB_TOP], 1u);
            const unsigned tg = og / nx;
            if (og + 1u == (tg + 1u) * nx) xb_add(&bar[XB_TOPGEN], 1u);
            else XB_SPIN(xb_ld(&bar[XB_TOPGEN]) == tg, bar);
            __builtin_amdgcn_fence(__ATOMIC_ACQUIRE, "agent");
            xb_add(&bar[XB_XGEN(b.x)], 1u);
            asm volatile("s_waitcnt vmcnt(0)" ::: "memory");
        } else {
            XB_SPIN(xb_ld(&bar[XB_XGEN(b.x)]) == gen, bar);
            __builtin_amdgcn_fence(__ATOMIC_ACQUIRE, "agent");
            asm volatile("s_waitcnt vmcnt(0)" ::: "memory");
        }
    }
    __syncthreads();
}
#define GBAR() do { XcdBarrier xb_ = xbar; unsigned xx_ = xb_.x; asm volatile("" : "+s"(xx_)); xb_.x = xx_; xcd_barrier(xb_); } while (0)
__global__ void __launch_bounds__(NT, 2) fwd_megakernel(Params p) {
  char* lds = g_lds;
  cg::grid_group grid = cg::this_grid();
  PG8_LAS unsigned char* lds3 = (PG8_LAS unsigned char*)lds;
  volatile PG8_LAS unsigned* xst = (volatile PG8_LAS unsigned*)(lds3 + ITEM_OFF);
  if (threadIdx.x == 0) { xst[0] = 0u; xst[1] = 0u; }
  __syncthreads();
  const XcdBarrier xbar = xcd_barrier_post((unsigned*)(p.ws + OFF_BAR), xst);
  prologue(p, lds);
  GSYNC();
#if DEBUG_CHECK && DBG_W
  chk_weights(p);
#endif
  const float* Xold = p.x;
  for (int l = 0; l < DEPTH; ++l) {
    float* Xnew = p.out;
    {
      pg8::Gemm g{p.XB_(), p.Wi_() + (size_t)l * NP * 1024, T_, NP, 1024}; pg8::StaticOrder S; S.init(T_, NP, (int)gridDim.x, (int)blockIdx.x);
      {
        PG8_LAS float* rsT = (PG8_LAS float*)(lds3 + 131072);
        PG8_LAS int* ulist = (PG8_LAS int*)(lds3 + 131072 + 14336);
        int tid = threadIdx.x; asm volatile("" : "+v"(tid));
        const float* SSl = p.SS_() + (size_t)l * T_ * 16;
        if (tid < 16) { pg8::Unit u; u.pm = 0; u.pn = 0; const bool ok = tid < 14 && S.next(tid, u); ulist[tid] = ok ? ((u.pm << 8) | u.pn) : -1; }
        __syncthreads();
        for (int idx = tid; idx < 14 * 256; idx += NT) { const int key = ulist[idx >> 8]; if (key >= 0) rsT[idx] = row_rs(SSl, (key >> 8) * 256 + (idx & 255)); }
        __syncthreads();
      }
      EpiInproj E{p.P_()};
      pg8::gemm_phase<EpiInproj, pg8::StaticOrder, INPROJ_ALIGN, DBG_SP2>(lds3, g, S, E);
#if PROBE_REP == 5
      GBAR();
      pg8::gemm_phase<EpiInproj, pg8::StaticOrder, true, DBG_SP2>(lds3, g, S, E);
#endif
#if PROBE_REP == 8
      GBAR();
      { EpiNullProbe E2{p.scal_() + 32, p.scal_() + 16, p.SS_() + (size_t)l * T_ * 16}; pg8::gemm_phase<EpiNullProbe, pg8::StaticOrder, true, DBG_SP2>(lds3, g, S, E2); }
#endif
    }
    GBAR();
#if DEBUG_CHECK && DBG_IN
    chk_inproj(p, l);
#endif
    phase_m1<0>(p, l, lds);
#if PROBE_REP >= 1 && PROBE_REP <= 4
    GBAR();
    if (blockIdx.x == 0 && threadIdx.x == 0) p.cnt_()[l] = 0;
    GBAR();
    phase_m1<(PROBE_REP & 3)>(p, l, lds);
#endif
    GBAR();
    gla_scan(p);
    GBAR();
    phase_m3(p, l, lds);
#if PROBE_REP == 7
    GBAR(); GBAR(); GBAR(); GBAR(); GBAR(); GBAR(); GBAR(); GBAR();
#endif
#if PROBE_REP == 6
    GBAR();
    if (blockIdx.x == 0 && threadIdx.x == 0) p.cnt_()[4 + l] = 0;
    GBAR();
    phase_m3(p, l, lds);
#endif
    GBAR();
#if DEBUG_CHECK
#if DBG_GLA
    chk_gla(p, l, lds);
#endif
#if DBG_DIFF
    chk_diff(p, l, lds);
#endif
#if DBG_DIL
    chk_dil(p, l);
#endif
    __syncthreads();
#endif
    {
      pg8::Gemm g{p.Y_(), p.Wb_() + (size_t)l * 3 * 1024 * 512, 3 * T_, 3 * 1024, 512}; MergeOrder S{(int)gridDim.x, (int)blockIdx.x};
      EpiMerge E{p.P_(), p.MIX_()};
#ifndef NO_MERGE
      pg8::gemm_phase<EpiMerge, MergeOrder, true, DBG_SP2>(lds3, g, S, E);
#endif
    }
    GBAR();
#if DEBUG_CHECK && DBG_MERGE
    chk_merge(p, l);
#endif
    {
      pg8::Gemm g{p.MIX_(), p.Wo_() + (size_t)l * 1024 * 1024, T_, 1024, 1024}; pg8::StaticOrder S; S.init(T_, 1024, (int)gridDim.x, (int)blockIdx.x);
      EpiOut E{l == 0 ? p.x : nullptr, p.XB_(), p.SS_() + (size_t)(l + 1) * T_ * 16};
#ifndef NO_OUT
      pg8::gemm_phase<EpiOut, pg8::StaticOrder, true, DBG_SP2>(lds3, g, S, E);
#endif
    }
    GBAR();
#if DEBUG_CHECK
    GBAR();
#endif
    Xold = Xnew;
  }
  phase_final(p);
#if DEBUG_CHECK
  GBAR();
  if (blockIdx.x == 0 && threadIdx.x == 0) {
    for (int s = 1; s < 16; ++s) {
      const int tot = p.cnt_()[16 + s], bad = p.cnt_()[32 + s];
      if (bad > 0) { int dec = (bad * 10) / (tot > 0 ? tot : 1); if (dec > 9) dec = 9; p.out[0] = 1000.f * s + 100.f * dec;
        if (s == 3) p.out[0] = 100.f * (float)(1 + (p.cnt_()[50] & 15));
        break; }
    }
  }
#endif
}

extern "C" void kernel_launch(void* const* d_in, const int* in_sizes, int n_in, void* d_out, int out_size,
                              void* d_ws, size_t ws_size, hipStream_t stream) {
  static int grid_blocks = 0;
  if (!grid_blocks) {
    int dev = 0, cus = 0, per_cu = 0;
    (void)hipGetDevice(&dev);
    (void)hipDeviceGetAttribute(&cus, hipDeviceAttributeMultiprocessorCount, dev);
    if (hipFuncSetAttribute((const void*)fwd_megakernel, hipFuncAttributeMaxDynamicSharedMemorySize, LDS_BYTES) != hipSuccess) fprintf(stderr, "hipFuncSetAttribute(dynamic LDS) failed\n");
    (void)hipOccupancyMaxActiveBlocksPerMultiprocessor(&per_cu, fwd_megakernel, NT, LDS_BYTES);
    (void)hipGetLastError();
    grid_blocks = cus;
  }
  Params p{};
  p.x = (const float*)d_in[0]; p.norm_g = (const float*)d_in[1]; p.w_in = (const float*)d_in[2]; p.gate_up = (const float*)d_in[3];
  p.gate_b = (const float*)d_in[4]; p.gla_norm_g = (const float*)d_in[5]; p.diff_lambda = (const float*)d_in[6]; p.diff_norm_g = (const float*)d_in[7];
  p.w_branch = (const float*)d_in[8]; p.w_out = (const float*)d_in[9]; p.final_g = (const float*)d_in[10];
  p.out = (float*)d_out;
  p.ws = (char*)d_ws;
  if (WS_END > ws_size) { fprintf(stderr, "workspace too small: need %zu have %zu\n", (size_t)WS_END, ws_size); return; }
  if (hipMemsetAsync((char*)d_ws + OFF_BAR, 0, 16384, stream) != hipSuccess) { fprintf(stderr, "barrier memset failed\n"); return; }
  void* args[] = {&p};
  hipError_t e = hipLaunchCooperativeKernel((void*)fwd_megakernel, dim3(grid_blocks), dim3(NT), args, LDS_BYTES, stream);
  if (e != hipSuccess) fprintf(stderr, "cooperative launch failed: %s (grid %d)\n", hipGetErrorString(e), grid_blocks);
}
```

```cpp
#include <hip/hip_runtime.h>
#include <hip/hip_cooperative_groups.h>
#include <cstdio>
#include <cstdint>
namespace cg = cooperative_groups;

#ifndef SELF_POISON
#define SELF_POISON 0
#endif
#ifndef INPROJ_ALIGN
#define INPROJ_ALIGN true
#endif
#ifndef PROBE_REP
#define PROBE_REP 0
#endif
#ifndef DBG_W
#define DBG_W 0
#define DBG_IN 0
#define DBG_GLA 1
#define DBG_DIFF 0
#define DBG_DIL 1
#define DBG_MERGE 1
#define DBG_OUT 1
#endif
#ifndef DBG_ENC
#define DBG_ENC 0
#endif
#ifndef DBG_SP2
#define DBG_SP2 true
#endif
#ifndef DEBUG_CHECK
#define DEBUG_CHECK 0
#endif

namespace pg8 {
#define PG8_LAS __attribute__((address_space(3)))
typedef unsigned short bf16_t;
typedef short bf16x8 __attribute__((ext_vector_type(8)));
typedef float f32x4 __attribute__((ext_vector_type(4)));
typedef unsigned u32x4 __attribute__((ext_vector_type(4)));
constexpr int BM = 256, BK = 64, HALF = 128, HTB = HALF * BK * 2  , STAGE_BYTES = 8 * HTB, NXCD = 8, WGM = 8;

__host__ __device__ __forceinline__ int lds_byte(int r, int c) { const int st = (r >> 4) * 2 + (c >> 5), rr = r & 15, cc = c & 31, ob = rr * 64 + cc * 2; return st * 1024 + (ob ^ (((ob >> 9) & 1) << 5)); }
__host__ __device__ __forceinline__ void stage_rc(int b, int& R, int& C) { const int st = b / 1024, sb = b % 1024, swz = sb ^ (((sb >> 9) & 1) << 5); R = (st >> 1) * 16 + swz / 64; C = (st & 1) * 32 + (swz % 64) / 2; }
__host__ __device__ __forceinline__ int perm32(int rho) { const int n = rho >> 4, i = rho & 15; return 8 * (i >> 2) + 4 * n + (i & 3); }

struct Unit { int pm, pn; };
struct Gemm { const bf16_t* A; const bf16_t* Bt; int M, N, K; };

struct StaticOrder {
    int nM, nN, nwg, G, c;
    __host__ __device__ void init(int M, int N, int G_, int c_) { nM = M / BM; nN = N / BM; nwg = nM * nN; G = G_; c = c_; }
    __host__ __device__ bool next(int i, Unit& u) const {
        const long L = (long)i * G + c; if (L >= nwg) return false;
        int wgid = (int)L; { const int q = nwg / NXCD, r = nwg % NXCD, xcd = wgid % NXCD, off = wgid / NXCD; wgid = (xcd < r ? xcd * (q + 1) : r * (q + 1) + (xcd - r) * q) + off; }
        const int nig = WGM * nN, gid = wgid / nig, fm = gid * WGM, gsz = (nM - fm) < WGM ? (nM - fm) : WGM;
        u.pm = fm + ((wgid % nig) % gsz); u.pn = (wgid % nig) / gsz; return true;
    }
    __device__ __forceinline__ void a_ready(const Unit&) const {}
    __device__ __forceinline__ void done(const Unit&) const {}
};
template <class Epi, class Sched, bool ALIGN_EPI = false, bool SP2 = false>
__device__ __forceinline__ void gemm_phase(PG8_LAS unsigned char* lds, const Gemm g, const Sched& S, const Epi& E) {
    int tid_l = threadIdx.x; asm volatile("" : "+v"(tid_l));
    const int tid = tid_l, wid = __builtin_amdgcn_readfirstlane(tid >> 6), lane = tid & 63, wr = wid >> 2, wc = wid & 3, fr = lane & 15, fq = lane >> 4;
    const int K = g.K, nt = K / BK;
    unsigned voffA[2], voffB[2];
#pragma unroll
    for (int i = 0; i < 2; ++i) { int R, C; stage_rc(tid * 16 + i * 8192, R, C); const int Rb = Epi::PERM ? ((R & ~31) + perm32(R & 31)) : R;
        voffA[i] = (unsigned)(R * K + C) * 2u; voffB[i] = (unsigned)(Rb * K + C) * 2u; }
    const size_t kstep = (size_t)(BK * 2);
    const size_t hstep = (size_t)HALF * K * 2;
    const size_t tstep = 2 * hstep;
    const unsigned ldsw = (unsigned)wid * 1024u;
    const int aoff = lds_byte(wr * 64 + fr, fq * 8), boff = lds_byte(wc * 32 + fr, fq * 8);
#define PG8_SA(b, h) (((b) * 2 + (h)) * HTB)
#define PG8_SB(b, h) ((4 + (b) * 2 + (h)) * HTB)
#define PG8_STAGE(bufoff, gbase, voff) do { _Pragma("unroll") for (int _i = 0; _i < 2; ++_i) \
        __builtin_amdgcn_global_load_lds((const unsigned*)((const char*)(gbase) + (voff)[_i]), (PG8_LAS unsigned*)(lds + (bufoff) + ldsw + _i * 8192), 16, 0, 0); } while (0)
#define PG8_LDA(dst, b, h) do { _Pragma("unroll") for (int m = 0; m < 4; ++m) _Pragma("unroll") for (int k = 0; k < 2; ++k) dst[m][k] = *(const PG8_LAS bf16x8*)(lds + PG8_SA(b, h) + aoff + m * 2048 + k * 1024); } while (0)
#define PG8_LDB(dst, b, h) do { _Pragma("unroll") for (int n = 0; n < 2; ++n) _Pragma("unroll") for (int k = 0; k < 2; ++k) dst[n][k] = *(const PG8_LAS bf16x8*)(lds + PG8_SB(b, h) + boff + n * 2048 + k * 1024); } while (0)
#define PG8_MMA(ai, bj, At, Bt) do { __builtin_amdgcn_s_setprio(1); _Pragma("unroll") for (int m = 0; m < 4; ++m) _Pragma("unroll") for (int n = 0; n < 2; ++n) _Pragma("unroll") for (int k = 0; k < 2; ++k) \
        acc[ai][bj][m][n] = __builtin_amdgcn_mfma_f32_16x16x32_bf16(Bt[n][k], At[m][k], acc[ai][bj][m][n], 0, 0, 0); __builtin_amdgcn_s_setprio(0); } while (0)
#define PG8_WAIT_V(n) asm volatile("s_waitcnt vmcnt(" #n ")" ::: "memory")
#define PG8_WAIT_L(n) asm volatile("s_waitcnt lgkmcnt(" #n ")" ::: "memory")
#define PG8_BAR __builtin_amdgcn_s_barrier()
#define PG8_SCHED __builtin_amdgcn_sched_barrier(0)
    Unit cur, nxt; int ui = 0;
    if (!S.next(0, cur)) return;
    f32x4 acc[2][2][4][2];
#pragma unroll
    for (int a = 0; a < 2; ++a)
#pragma unroll
        for (int b = 0; b < 2; ++b)
#pragma unroll
            for (int m = 0; m < 4; ++m)
#pragma unroll
                for (int n = 0; n < 2; ++n) acc[a][b][m][n] = (f32x4){0.f, 0.f, 0.f, 0.f};
    bf16x8 At[4][2], B0[2][2], B1[2][2];
    const char* cA = (const char*)g.A + (size_t)cur.pm * tstep; const char* cB = (const char*)g.Bt + (size_t)cur.pn * tstep;
    S.a_ready(cur);
    if constexpr (SP2) {
        PG8_STAGE(PG8_SB(0, 0), cB, voffB); PG8_STAGE(PG8_SB(0, 1), cB + hstep, voffB); PG8_STAGE(PG8_SA(0, 0), cA, voffA); PG8_STAGE(PG8_SA(0, 1), cA + hstep, voffA);
        if (wr == 1) PG8_BAR;
        PG8_WAIT_V(2); PG8_BAR;
        PG8_STAGE(PG8_SB(1, 0), cB + kstep, voffB); PG8_STAGE(PG8_SA(1, 0), cA + kstep, voffA); PG8_STAGE(PG8_SB(1, 1), cB + hstep + kstep, voffB);
        PG8_WAIT_V(6); PG8_BAR;
    } else {
        PG8_STAGE(PG8_SB(0, 0), cB, voffB); PG8_STAGE(PG8_SA(0, 0), cA, voffA); PG8_STAGE(PG8_SB(0, 1), cB + hstep, voffB); PG8_STAGE(PG8_SA(0, 1), cA + hstep, voffA);
        if (wr == 1) PG8_BAR;
        PG8_WAIT_V(4); PG8_BAR;
        PG8_STAGE(PG8_SB(1, 0), cB + kstep, voffB); PG8_STAGE(PG8_SA(1, 0), cA + kstep, voffA); PG8_STAGE(PG8_SB(1, 1), cB + hstep + kstep, voffB);
        PG8_WAIT_V(6); PG8_BAR;
    }
    for (;;) {
        const bool has_next = S.next(ui + 1, nxt);
        const char* nA = has_next ? (const char*)g.A + (size_t)nxt.pm * tstep : cA; const char* nB = has_next ? (const char*)g.Bt + (size_t)nxt.pn * tstep : cB;
        for (int t = 0; t < nt; t += 2) {
            const bool last = (t == nt - 2);
            const char* a1 = cA + (size_t)(t + 1) * kstep;
            const char* a2 = last ? nA : cA + (size_t)(t + 2) * kstep; const char* b2 = last ? nB : cB + (size_t)(t + 2) * kstep;
            const char* a3 = a2 + kstep; const char* b3 = b2 + kstep;
            if (last && has_next) S.a_ready(nxt);
            if constexpr (SP2) {
            PG8_LDB(B0, 0, 0); PG8_LDB(B1, 0, 1); PG8_SCHED; PG8_LDA(At, 0, 0); PG8_STAGE(PG8_SA(1, 1), a1 + hstep, voffA);
            PG8_WAIT_V(8); PG8_WAIT_L(0); PG8_BAR; PG8_MMA(0, 0, At, B0); PG8_MMA(0, 1, At, B1); PG8_BAR; PG8_SCHED;
            PG8_LDA(At, 0, 1); PG8_STAGE(PG8_SB(0, 0), b2, voffB); PG8_STAGE(PG8_SB(0, 1), b2 + hstep, voffB); PG8_STAGE(PG8_SA(0, 0), a2, voffA);
            PG8_WAIT_V(8); PG8_WAIT_L(0); PG8_BAR; PG8_MMA(1, 0, At, B0); PG8_MMA(1, 1, At, B1); PG8_BAR; PG8_SCHED;
            PG8_LDB(B0, 1, 0); PG8_LDB(B1, 1, 1); PG8_SCHED; PG8_LDA(At, 1, 0); PG8_STAGE(PG8_SA(0, 1), a2 + hstep, voffA);
            PG8_WAIT_V(8); PG8_WAIT_L(0); PG8_BAR; PG8_MMA(0, 0, At, B0); PG8_MMA(0, 1, At, B1); PG8_BAR; PG8_SCHED;
            PG8_LDA(At, 1, 1); PG8_STAGE(PG8_SB(1, 0), b3, voffB); PG8_STAGE(PG8_SB(1, 1), b3 + hstep, voffB); PG8_STAGE(PG8_SA(1, 0), a3, voffA);
            PG8_WAIT_V(8); PG8_WAIT_L(0); PG8_BAR; PG8_MMA(1, 0, At, B0); PG8_MMA(1, 1, At, B1); PG8_BAR; PG8_SCHED;
            } else {
            PG8_LDB(B0, 0, 0); PG8_SCHED; PG8_LDA(At, 0, 0); PG8_STAGE(PG8_SA(1, 1), a1 + hstep, voffA);
            PG8_WAIT_L(8); PG8_BAR; PG8_WAIT_L(0); PG8_MMA(0, 0, At, B0); PG8_BAR; PG8_SCHED;
            PG8_LDB(B1, 0, 1); PG8_STAGE(PG8_SB(0, 0), b2, voffB);
            PG8_BAR; PG8_WAIT_L(0); PG8_MMA(0, 1, At, B1); PG8_BAR;
            PG8_LDA(At, 0, 1); PG8_STAGE(PG8_SA(0, 0), a2, voffA);
            PG8_BAR; PG8_WAIT_L(0); PG8_MMA(1, 0, At, B0); PG8_BAR; PG8_SCHED;
            PG8_STAGE(PG8_SB(0, 1), b2 + hstep, voffB);
            PG8_WAIT_V(6); PG8_BAR; PG8_MMA(1, 1, At, B1); PG8_BAR;
            PG8_LDB(B0, 1, 0); PG8_SCHED; PG8_LDA(At, 1, 0); PG8_STAGE(PG8_SA(0, 1), a2 + hstep, voffA);
            PG8_WAIT_L(8); PG8_BAR; PG8_WAIT_L(0); PG8_MMA(0, 0, At, B0); PG8_BAR; PG8_SCHED;
            PG8_LDB(B1, 1, 1); PG8_STAGE(PG8_SB(1, 0), b3, voffB);
            PG8_BAR; PG8_WAIT_L(0); PG8_MMA(0, 1, At, B1); PG8_BAR;
            PG8_LDA(At, 1, 1); PG8_STAGE(PG8_SA(1, 0), a3, voffA);
            PG8_BAR; PG8_WAIT_L(0); PG8_MMA(1, 0, At, B0); PG8_BAR; PG8_SCHED;
            PG8_STAGE(PG8_SB(1, 1), b3 + hstep, voffB);
            PG8_WAIT_V(6); PG8_BAR; PG8_MMA(1, 1, At, B1); PG8_BAR;
            }
        }
        if constexpr (ALIGN_EPI) { if (wr == 0) PG8_BAR; }
        bool zero_acc = true;
        if constexpr (!Epi::AFTER_DRAIN) { zero_acc = E(acc, cur, wr, wc, fr, fq); S.done(cur); }
        if (!has_next) break;
        if (zero_acc) {
#pragma unroll
        for (int a = 0; a < 2; ++a)
#pragma unroll
            for (int b = 0; b < 2; ++b)
#pragma unroll
                for (int m = 0; m < 4; ++m)
#pragma unroll
                    for (int n = 0; n < 2; ++n) acc[a][b][m][n] = (f32x4){0.f, 0.f, 0.f, 0.f};
        }
        cur = nxt; cA = nA; cB = nB; ++ui;
        if constexpr (ALIGN_EPI) { if (wr == 1) PG8_BAR; }
    }
    PG8_WAIT_V(0);
    if constexpr (!ALIGN_EPI) { if (wr == 0) PG8_BAR; }
    PG8_BAR;
    if constexpr (Epi::AFTER_DRAIN) { E.fused(acc, cur, wr, wc, fr, fq, lds, wid, lane); S.done(cur); }
#undef PG8_SA
#undef PG8_SB
#undef PG8_STAGE
#undef PG8_LDA
#undef PG8_LDB
#undef PG8_MMA
#undef PG8_WAIT_V
#undef PG8_WAIT_L
#undef PG8_BAR
#undef PG8_SCHED
}
}

typedef unsigned short bf16_t;
typedef short bf16x8 __attribute__((ext_vector_type(8)));
typedef float f32x16 __attribute__((ext_vector_type(16)));
typedef float f32x4 __attribute__((ext_vector_type(4)));
typedef float f32x2 __attribute__((ext_vector_type(2)));
typedef __bf16 bf16x2_t __attribute__((ext_vector_type(2)));
typedef unsigned u32x4 __attribute__((ext_vector_type(4)));
typedef unsigned u32x2 __attribute__((ext_vector_type(2)));

#define DI __device__ __forceinline__
#define MFMA32(a, b, c) __builtin_amdgcn_mfma_f32_32x32x16_bf16((a), (b), (c), 0, 0, 0)

constexpr int T_ = 16384, S_ = 2048, DM = 1024, NP = 8960, DEPTH = 4, NT = 512;
constexpr int AQ = 0, AK = 256, AV = 512, AG = 1024, BQ = 1536, BKc = 2048, BV = 2560, BG = 3072, CQ = 3584, CK = 4096, CV = 4608, CG = 5120, MG = 5632, LF = 8704;
constexpr int LDS_BYTES = 147456, ITEM_OFF = LDS_BYTES - 16, GLA_HALF = 63488;
constexpr float EPS = 1e-6f, LOG2E = 1.4426950408889634f;

constexpr size_t OFF_WI = 0, OFF_WB = OFF_WI + (size_t)4 * NP * 1024 * 2, OFF_WO = OFF_WB + (size_t)12 * 1024 * 512 * 2, OFF_P = OFF_WO + (size_t)4 * 1024 * 1024 * 2,
                 OFF_XB = OFF_P + (size_t)T_ * NP * 2, OFF_Y = OFF_XB + (size_t)T_ * DM * 2, OFF_MIX = OFF_Y + (size_t)3 * T_ * 512 * 2, OFF_UT = OFF_MIX + (size_t)T_ * DM * 2,
                 OFF_QH = OFF_UT + (size_t)2 * 1024 * 8192 * 2, OFF_DEC = OFF_QH + (size_t)2 * 1024 * 4096 * 2, OFF_SS = OFF_DEC + (size_t)2 * 1024 * 64 * 4,
                 OFF_SCAL = OFF_SS + (size_t)5 * T_ * 16 * 4, OFF_CNT = OFF_SCAL + 256, OFF_LSE = OFF_CNT + 256, OFF_BAR = OFF_LSE + (size_t)2 * T_ * 8 * 4, WS_END = OFF_BAR + 16384;
struct Params {
  const float *x, *norm_g, *w_in, *gate_up, *gate_b, *gla_norm_g, *diff_lambda, *diff_norm_g, *w_branch, *w_out, *final_g;
  float* out; char* ws;
  __device__ __forceinline__ bf16_t* Wi_() const { return (bf16_t*)(ws + OFF_WI); }
  __device__ __forceinline__ bf16_t* Wb_() const { return (bf16_t*)(ws + OFF_WB); }
  __device__ __forceinline__ bf16_t* Wo_() const { return (bf16_t*)(ws + OFF_WO); }
  __device__ __forceinline__ bf16_t* P_() const { return (bf16_t*)(ws + OFF_P); }
  __device__ __forceinline__ bf16_t* XB_() const { return (bf16_t*)(ws + OFF_XB); }
  __device__ __forceinline__ bf16_t* Y_() const { return (bf16_t*)(ws + OFF_Y); }
  __device__ __forceinline__ bf16_t* MIX_() const { return (bf16_t*)(ws + OFF_MIX); }
  __device__ __forceinline__ float* OA_() const { return (float*)(ws + OFF_MIX); }
  __device__ __forceinline__ bf16_t* UT_() const { return (bf16_t*)(ws + OFF_UT); }
  __device__ __forceinline__ bf16_t* QH_() const { return (bf16_t*)(ws + OFF_QH); }
  __device__ __forceinline__ float* DEC_() const { return (float*)(ws + OFF_DEC); }
  __device__ __forceinline__ float* SS_() const { return (float*)(ws + OFF_SS); }
  __device__ __forceinline__ float* scal_() const { return (float*)(ws + OFF_SCAL); }
  __device__ __forceinline__ int* cnt_() const { return (int*)(ws + OFF_CNT); }
  __device__ __forceinline__ float* LSE_() const { return (float*)(ws + OFF_LSE); }
};

DI unsigned pk2(float lo, float hi) { f32x2 v = {lo, hi}; bf16x2_t b = __builtin_convertvector(v, bf16x2_t); return __builtin_bit_cast(unsigned, b); }
DI float bflo(unsigned u) { return __uint_as_float(u << 16); }
DI float bfhi(unsigned u) { return __uint_as_float(u & 0xffff0000u); }
DI float bf2f(bf16_t h) { return __uint_as_float(((unsigned)h) << 16); }
DI int crow(int reg, int hh) { return (reg & 3) + 8 * (reg >> 2) + 4 * hh; }
DI float ex2(float x) { return __builtin_amdgcn_exp2f(x); }
DI float siluf(float x) { return x * __builtin_amdgcn_rcpf(1.f + __expf(-x)); }
DI float sigmf(float x) { return __builtin_amdgcn_rcpf(1.f + __expf(-x)); }
DI float logsig(float z) { return fminf(z, 0.f) - __logf(1.f + __expf(-fabsf(z))); }
DI bf16x8 pack_step(const f32x16& x, int s) {
  u32x4 p;
  p[0] = pk2(x[8 * s + 0], x[8 * s + 1]); p[1] = pk2(x[8 * s + 2], x[8 * s + 3]);
  p[2] = pk2(x[8 * s + 4], x[8 * s + 5]); p[3] = pk2(x[8 * s + 6], x[8 * s + 7]);
  return __builtin_bit_cast(bf16x8, p);
}
DI bf16x8 cat2(u32x2 lo, u32x2 hi) { u32x4 v = {lo[0], lo[1], hi[0], hi[1]}; return __builtin_bit_cast(bf16x8, v); }
DI void tr4x8(const u32x4& r0, const u32x4& r1, const u32x4& r2, const u32x4& r3, u32x2 (&o)[8]) {
#pragma unroll
  for (int wd = 0; wd < 4; ++wd) {
    const unsigned a = r0[wd], b = r1[wd], c = r2[wd], d = r3[wd];
    o[2 * wd][0] = (a & 0xffffu) | (b << 16); o[2 * wd][1] = (c & 0xffffu) | (d << 16);
    o[2 * wd + 1][0] = (a >> 16) | (b & 0xffff0000u); o[2 * wd + 1][1] = (c >> 16) | (d & 0xffff0000u);
  }
}
#define LDS_BARRIER() do { asm volatile("s_waitcnt lgkmcnt(0)" ::: "memory"); __builtin_amdgcn_s_barrier(); asm volatile("" ::: "memory"); } while (0)
DI f32x16 zero16() { f32x16 z; for (int i = 0; i < 16; ++i) z[i] = 0.f; return z; }
DI float row_rs(const float* __restrict__ SSl, int t) {
  const f32x4 a = *(const f32x4*)(SSl + (size_t)t * 16), b = *(const f32x4*)(SSl + (size_t)t * 16 + 4);
  const f32x4 c = *(const f32x4*)(SSl + (size_t)t * 16 + 8), d = *(const f32x4*)(SSl + (size_t)t * 16 + 12);
  const float ss = (((a[0] + a[1]) + (a[2] + a[3])) + ((b[0] + b[1]) + (b[2] + b[3]))) + (((c[0] + c[1]) + (c[2] + c[3])) + ((d[0] + d[1]) + (d[2] + d[3])));
  return rsqrtf(ss * (1.f / 1024.f) + EPS);
}
DI int win_col(int n) {
  const bool rope = (n >= BQ && n < BV) || (n >= CQ && n < CV);
  if (rope) { const int p = n & 63; n = (n & ~63) + 32 * ((p >> 2) & 1) + 16 * (p >> 5) + 4 * ((p >> 3) & 3) + (p & 3); }
  if (n < 1536) return n;
  if (n < LF) return n + 32;
  if (n < LF + 32) return n - LF + 1536;
  return -1;
}
DI float win_scale(int n) {
  if (n < AK) return 0.125f;
  if ((n >= BQ && n < BKc) || (n >= CQ && n < CK)) return 0.125f * LOG2E;
  return 1.f;
}

extern __shared__ __attribute__((aligned(16))) char g_lds[];
struct EpiInproj {
  static constexpr bool PERM = true, AFTER_DRAIN = false;
  bf16_t* P;
  DI bool operator()(pg8::f32x4 (&acc)[2][2][4][2], const pg8::Unit& u, int wr, int wc, int fr, int fq) const {
    const int colt = u.pn * 256;
    const PG8_LAS unsigned char* l3 = (const PG8_LAS unsigned char*)g_lds;
    const PG8_LAS int* ulist = (const PG8_LAS int*)(l3 + 131072 + 14336);
    const int key = (u.pm << 8) | u.pn; int slot = 0;
#pragma unroll
    for (int i = 1; i < 14; ++i) slot = ulist[i] == key ? i : slot;
    const PG8_LAS float* rsrow = (const PG8_LAS float*)(l3 + 131072) + slot * 256;
    const bool rope = (colt >= BQ && colt < BV) || (colt >= CQ && colt < CV);
    const bool gate = colt >= MG && colt < LF;
#pragma unroll
    for (int ai = 0; ai < 2; ++ai)
#pragma unroll
      for (int m = 0; m < 4; ++m) {
        const int row = u.pm * 256 + ai * 128 + wr * 64 + m * 16 + fr;
        const float rs = rsrow[ai * 128 + wr * 64 + m * 16 + fr];
        bf16_t* rowp = P + (size_t)row * NP;
#pragma unroll
        for (int bj = 0; bj < 2; ++bj) {
          const f32x4 v0 = acc[ai][bj][m][0] * rs, v1 = acc[ai][bj][m][1] * rs;
          if (gate) {
            float q[8];
#pragma unroll
            for (int j = 0; j < 4; ++j) { q[j] = 1.f + __expf(fminf(-v0[j], 80.f)); q[4 + j] = 1.f + __expf(fminf(-v1[j], 80.f)); }
            u32x4 o = {pk2(q[0], q[1]), pk2(q[2], q[3]), pk2(q[4], q[5]), pk2(q[6], q[7])};
            *(u32x4*)(rowp + colt + bj * 128 + wc * 32 + 8 * fq) = o;
          } else if (!rope) {
            u32x4 o = {pk2(v0[0], v0[1]), pk2(v0[2], v0[3]), pk2(v1[0], v1[1]), pk2(v1[2], v1[3])};
            *(u32x4*)(rowp + colt + bj * 128 + wc * 32 + 8 * fq) = o;
          } else {
            const int d0 = 16 * (wc & 1) + 4 * fq;
            const float pos = (float)(row & (S_ - 1));
            float y1[4], y2[4];
#pragma unroll
            for (int j = 0; j < 4; ++j) {
              const float inv = ex2(-(float)(d0 + j) * 0.41524101186f);
              float rev = (pos * inv) * 0.15915494309189535f;
              rev -= floorf(rev);
              const float sn = __builtin_amdgcn_sinf(rev), cs = __builtin_amdgcn_cosf(rev);
              y1[j] = v0[j] * cs - v1[j] * sn; y2[j] = v1[j] * cs + v0[j] * sn;
            }
            bf16_t* hp = rowp + colt + bj * 128 + (wc >> 1) * 64 + d0;
            u32x2 o1 = {pk2(y1[0], y1[1]), pk2(y1[2], y1[3])}, o2 = {pk2(y2[0], y2[1]), pk2(y2[2], y2[3])};
            *(u32x2*)hp = o1; *(u32x2*)(hp + 32) = o2;
          }
        }
      }
    return true;
  }
};
struct EpiNullProbe {
  static constexpr bool PERM = true, AFTER_DRAIN = false;
  float* sink; const float* flag; const float* SSp;
  DI bool operator()(pg8::f32x4 (&acc)[2][2][4][2], const pg8::Unit& u, int wr, int wc, int fr, int fq) const {
    float rsum = 0.f;
#pragma unroll
    for (int ai = 0; ai < 2; ++ai)
#pragma unroll
      for (int m = 0; m < 4; ++m) rsum += row_rs(SSp, u.pm * 256 + ai * 128 + wr * 64 + m * 16 + fr);
    if (rsum == 12345.678f) {
      float s = 0.f;
#pragma unroll
      for (int ai = 0; ai < 2; ++ai)
#pragma unroll
        for (int bj = 0; bj < 2; ++bj)
#pragma unroll
          for (int m = 0; m < 4; ++m) s += acc[ai][bj][m][0][0] + acc[ai][bj][m][1][3] + acc[ai][bj][m][0][2] + acc[ai][bj][m][1][1];
      sink[u.pm * 64 + fr] = s;
    }
    return true;
  }
};
struct EpiMerge {
  static constexpr bool PERM = true, AFTER_DRAIN = false;
  const bf16_t* P; bf16_t* MIX;
  DI bool operator()(pg8::f32x4 (&acc)[2][2][4][2], const pg8::Unit& u, int wr, int wc, int fr, int fq) const {
    const int g = u.pn >> 2, colt = (u.pn & 3) * 256, rowt = (u.pm & 63) * 256;
#pragma unroll
    for (int ai = 0; ai < 2; ++ai)
#pragma unroll
      for (int m = 0; m < 4; ++m) {
        const int row = rowt + ai * 128 + wr * 64 + m * 16 + fr;
#pragma unroll
        for (int bj = 0; bj < 2; ++bj) {
          const int col0 = colt + bj * 128 + wc * 32 + 8 * fq;
          const u32x4 ga = *(const u32x4*)(P + (size_t)row * NP + MG + g * 1024 + col0);
          float f[8] = {__builtin_amdgcn_rcpf(bflo(ga[0])), __builtin_amdgcn_rcpf(bfhi(ga[0])), __builtin_amdgcn_rcpf(bflo(ga[1])), __builtin_amdgcn_rcpf(bfhi(ga[1])),
                        __builtin_amdgcn_rcpf(bflo(ga[2])), __builtin_amdgcn_rcpf(bfhi(ga[2])), __builtin_amdgcn_rcpf(bflo(ga[3])), __builtin_amdgcn_rcpf(bfhi(ga[3]))};
          if (g < 2) {
            const u32x4 gb = *(const u32x4*)(P + (size_t)row * NP + MG + (g + 1) * 1024 + col0);
            f[0] *= bflo(gb[0]); f[1] *= bfhi(gb[0]); f[2] *= bflo(gb[1]); f[3] *= bfhi(gb[1]); f[4] *= bflo(gb[2]); f[5] *= bfhi(gb[2]); f[6] *= bflo(gb[3]); f[7] *= bfhi(gb[3]);
          }
#pragma unroll
          for (int j = 0; j < 4; ++j) { acc[ai][bj][m][0][j] *= f[j]; acc[ai][bj][m][1][j] *= f[4 + j]; }
          if (g == 2) {
            const pg8::f32x4 v0 = acc[ai][bj][m][0], v1 = acc[ai][bj][m][1];
            u32x4 o = {pk2(v0[0], v0[1]), pk2(v0[2], v0[3]), pk2(v1[0], v1[1]), pk2(v1[2], v1[3])};
            *(u32x4*)(MIX + (size_t)row * DM + col0) = o;
          }
        }
      }
    return g == 2;
  }
};
struct MergeOrder {
  int G, c;
  DI bool next(int i, pg8::Unit& u) const {
    const int tile = c + (i / 3) * G, g = i % 3;
    if (tile >= 256) return false;
    u.pm = g * 64 + (tile >> 2); u.pn = g * 4 + (tile & 3); return true;
  }
  DI void a_ready(const pg8::Unit&) const {}
  DI void done(const pg8::Unit&) const {}
};
struct EpiOut {
  static constexpr bool PERM = true, AFTER_DRAIN = false;
  const float* X0; bf16_t* XB; float* SSn;
  DI bool operator()(pg8::f32x4 (&acc)[2][2][4][2], const pg8::Unit& u, int wr, int wc, int fr, int fq) const {
    const int colt = u.pn * 256;
#pragma unroll
    for (int ai = 0; ai < 2; ++ai)
#pragma unroll
      for (int m = 0; m < 4; ++m) {
        const int row = u.pm * 256 + ai * 128 + wr * 64 + m * 16 + fr;
        float ss = 0.f;
#pragma unroll
        for (int bj = 0; bj < 2; ++bj) {
          const size_t off = (size_t)row * DM + colt + bj * 128 + wc * 32 + 8 * fq;
          pg8::f32x4 x0, x1;
          if (X0) { x0 = *(const pg8::f32x4*)(X0 + off); x1 = *(const pg8::f32x4*)(X0 + off + 4); }
          else { const u32x4 xb = *(const u32x4*)(XB + off); x0 = (pg8::f32x4){bflo(xb[0]), bfhi(xb[0]), bflo(xb[1]), bfhi(xb[1])}; x1 = (pg8::f32x4){bflo(xb[2]), bfhi(xb[2]), bflo(xb[3]), bfhi(xb[3])}; }
          x0 += acc[ai][bj][m][0]; x1 += acc[ai][bj][m][1];
          u32x4 o = {pk2(x0[0], x0[1]), pk2(x0[2], x0[3]), pk2(x1[0], x1[1]), pk2(x1[2], x1[3])};
          *(u32x4*)(XB + off) = o;
          const float r0 = bflo(o[0]), r1 = bfhi(o[0]), r2 = bflo(o[1]), r3 = bfhi(o[1]), r4 = bflo(o[2]), r5 = bfhi(o[2]), r6 = bflo(o[3]), r7 = bfhi(o[3]);
          ss += ((r0 * r0 + r1 * r1) + (r2 * r2 + r3 * r3)) + ((r4 * r4 + r5 * r5) + (r6 * r6 + r7 * r7));
        }
        ss += __shfl_xor(ss, 16); ss += __shfl_xor(ss, 32);
        if (fq == 0) SSn[(size_t)row * 16 + u.pn * 4 + wc] = ss;
      }
    return true;
  }
};

DI void conv_tile(bool active, const float* __restrict__ src, int ld, int kind, const float* __restrict__ rs, bf16_t* __restrict__ dst, int K, int n0, int k0, char* ldsh, int tid) {
  float* tl = (float*)ldsh;
  if (active) {
    const int nn = tid & 63, n = n0 + nn;
    const int col = kind == 0 ? win_col(n) : n;
    const float cs = kind == 0 ? win_scale(n) : 1.f;
    float vv[16];
#pragma unroll
    for (int i = 0; i < 16; ++i) vv[i] = col >= 0 ? src[(size_t)(k0 + (tid >> 6) + 4 * i) * ld + col] : 0.f;
#pragma unroll
    for (int i = 0; i < 16; ++i) {
      const int kk = (tid >> 6) + 4 * i;
      float v = vv[i] * cs; if (rs) v *= rs[k0 + kk];
      tl[kk * 65 + nn] = v;
    }
  }
  __syncthreads();
  if (active) {
    const int nl = tid >> 2, kq = tid & 3;
    u32x4 o0, o1;
#pragma unroll
    for (int j = 0; j < 4; ++j) {
      o0[j] = pk2(tl[(kq * 16 + 2 * j) * 65 + nl], tl[(kq * 16 + 2 * j + 1) * 65 + nl]);
      o1[j] = pk2(tl[(kq * 16 + 8 + 2 * j) * 65 + nl], tl[(kq * 16 + 8 + 2 * j + 1) * 65 + nl]);
    }
    bf16_t* dp = dst + (size_t)(n0 + nl) * K + k0 + kq * 16;
    *(u32x4*)dp = o0; *(u32x4*)(dp + 8) = o1;
  }
  __syncthreads();
}

DI void prologue(const Params& p, char* lds) {
  int tidf = threadIdx.x; asm volatile("" : "+v"(tidf)); const int lane = tidf & 63, half = tidf >> 8, tid = tidf & 255;
  constexpr int NTN = NP / 64, NT_WI = 4 * NTN * 16, NT_WB = 12 * 16 * 8, NT_WO = 4 * 16 * 16, NT_ALL = NT_WI + NT_WB + NT_WO;
  for (int base = blockIdx.x * 2; base < NT_ALL; base += gridDim.x * 2) {
    const int tile = base + half; const bool act = tile < NT_ALL;
    char* ldsh = lds + half * 16896;
    if (tile < NT_WI) {
      const int l = tile / (NTN * 16), rem = tile % (NTN * 16), nt = rem >> 4, kt = rem & 15;
      conv_tile(act, p.w_in + (size_t)l * 1024 * 8736, 8736, 0, p.norm_g + l * 1024, p.Wi_() + (size_t)l * NP * 1024, 1024, nt * 64, kt * 64, ldsh, tid);
    } else if (tile < NT_WI + NT_WB) {
      const int t2 = tile - NT_WI, mtx = t2 >> 7, rem = t2 & 127, nt = rem >> 3, kt = rem & 7;
      conv_tile(act, p.w_branch + (size_t)mtx * 512 * 1024, 1024, 1, nullptr, p.Wb_() + (size_t)mtx * 1024 * 512, 512, nt * 64, kt * 64, ldsh, tid);
    } else {
      const int t2 = (act ? tile : NT_ALL - 1) - NT_WI - NT_WB, l = t2 >> 8, rem = t2 & 255, nt = rem >> 4, kt = rem & 15;
      conv_tile(act, p.w_out + (size_t)l * 1024 * 1024, 1024, 1, nullptr, p.Wo_() + (size_t)l * 1024 * 1024, 1024, nt * 64, kt * 64, ldsh, tid);
    }
  }
  const int gw = (blockIdx.x * NT + tidf) >> 6, nw = gridDim.x * (NT / 64);
  for (int t = gw; t < T_; t += nw) {
    float ss = 0.f;
#pragma unroll
    for (int i = 0; i < 4; ++i) {
      const f32x4 v = *(const f32x4*)(p.x + (size_t)t * DM + i * 256 + lane * 4);
      ss += v[0] * v[0] + v[1] * v[1] + v[2] * v[2] + v[3] * v[3];
      u32x2 o = {pk2(v[0], v[1]), pk2(v[2], v[3])};
      *(u32x2*)(p.XB_() + (size_t)t * DM + i * 256 + lane * 4) = o;
    }
#pragma unroll
    for (int s = 32; s > 0; s >>= 1) ss += __shfl_xor(ss, s);
    if (lane < 16) p.SS_()[(size_t)t * 16 + lane] = lane == 0 ? ss : 0.f;
  }
#if SELF_POISON
  {
    const size_t gt0 = (size_t)blockIdx.x * NT + tidf, gs0 = (size_t)gridDim.x * NT;
    u32x4 nanv = {0xffffffffu, 0xffffffffu, 0xffffffffu, 0xffffffffu};
    for (size_t i = gt0; i < (size_t)T_ * NP / 8; i += gs0) ((u32x4*)p.P_())[i] = nanv;
    for (size_t i = gt0; i < (size_t)T_ * 1536 / 8; i += gs0) ((u32x4*)p.Y_())[i] = nanv;
    for (size_t i = gt0; i < (size_t)T_ * DM / 8; i += gs0) ((u32x4*)p.MIX_())[i] = nanv;
    for (size_t i = gt0; i < (size_t)T_ * DM / 4; i += gs0) ((u32x4*)p.out)[i] = nanv;
  }
#endif
  const int gt = blockIdx.x * NT + tidf;
  if (gt < 64) p.cnt_()[gt] = 0;
  if (gt < DEPTH) {
    const int l = gt; const float* dl = p.diff_lambda + l * 256;
    float s1 = 0.f, s2 = 0.f;
    for (int i = 0; i < 64; ++i) { s1 += dl[i] * dl[64 + i]; s2 += dl[128 + i] * dl[192 + i]; }
    const float li = 0.8f - 0.6f * expf(-0.3f * (float)l);
    p.scal_()[l] = expf(s1) - expf(s2) + li; p.scal_()[4 + l] = li;
  }
}

#define DIFF_STEP(KR, VR, JT, CUR) do { \
    bf16_t* KsW = Ks + (1 - (CUR)) * 17408; bf16_t* VtW = KsW + 64 * 136; \
    const bf16_t* KsC = Ks + (CUR) * 17408; const bf16_t* VtC = KsC + 64 * 136; \
    if ((JT) + 1 < 32) { \
      _Pragma("unroll") \
      for (int i = 0; i < 2; ++i) *(u32x4*)(KsW + (krow_ + 32 * i) * 136 + kc) = KR[i]; \
      _Pragma("unroll") \
      for (int wd = 0; wd < 4; ++wd) { \
        const unsigned a = VR[0][wd], c = VR[1][wd]; \
        *(unsigned*)(VtW + (ec * 8 + 2 * wd) * 68 + 2 * kg2) = (a & 0xffffu) | (c << 16); \
        *(unsigned*)(VtW + (ec * 8 + 2 * wd + 1) * 68 + 2 * kg2) = (a >> 16) | (c & 0xffff0000u); \
      } \
    } \
    if ((JT) + 3 < 32) { \
      const bf16_t* base = Pb + (size_t)(((JT) + 3) * 64) * NP; \
      _Pragma("unroll") \
      for (int i = 0; i < 2; ++i) { \
        KR[i] = *(const u32x4*)(base + (size_t)(krow_ + 32 * i) * NP + BKc + h * 128 + kc); \
        VR[i] = *(const u32x4*)(base + (size_t)(2 * kg2 + i) * NP + BV + h * 128 + ec * 8); \
      } \
    } \
    f32x16 s0, s1; \
    __builtin_amdgcn_s_setprio(1); \
    _Pragma("unroll") \
    for (int ks = 0; ks < 4; ++ks) { \
      const bf16x8 k0 = *(const bf16x8*)(KsC + r * 136 + comp * 64 + ks * 16 + hh * 8); \
      const bf16x8 k1 = *(const bf16x8*)(KsC + (32 + r) * 136 + comp * 64 + ks * 16 + hh * 8); \
      if (ks == 0) { s0 = MFMA32(k0, qf[0], negm); s1 = MFMA32(k1, qf[0], negm); } \
      else { s0 = MFMA32(k0, qf[ks], s0); s1 = MFMA32(k1, qf[ks], s1); } \
    } \
    __builtin_amdgcn_s_setprio(0); \
    float mx = s0[0]; \
    _Pragma("unroll") \
    for (int i = 0; i < 16; ++i) { mx = fmaxf(mx, s0[i]); mx = fmaxf(mx, s1[i]); } \
    mx = fmaxf(mx, __shfl_xor(mx, 32)); \
    if (__any(mx > 8.f)) { \
      const float dl = fmaxf(mx, 0.f), alpha = ex2(-dl); \
      m += dl; lsum *= alpha; \
      _Pragma("unroll") \
      for (int i = 0; i < 16; ++i) { s0[i] -= dl; s1[i] -= dl; negm[i] = -m; } \
      _Pragma("unroll") \
      for (int et = 0; et < 4; ++et) \
        _Pragma("unroll") \
        for (int i = 0; i < 16; ++i) o[et][i] *= alpha; \
    } \
    float ps = 0.f; \
    _Pragma("unroll") \
    for (int i = 0; i < 16; ++i) { s0[i] = ex2(s0[i]); s1[i] = ex2(s1[i]); ps += s0[i] + s1[i]; } \
    lsum += ps; \
    __builtin_amdgcn_s_setprio(1); \
    _Pragma("unroll") \
    for (int u = 0; u < 2; ++u) \
      _Pragma("unroll") \
      for (int s = 0; s < 2; ++s) { \
        const bf16x8 pb = u == 0 ? pack_step(s0, s) : pack_step(s1, s); \
        _Pragma("unroll") \
        for (int et = 0; et < 4; ++et) { \
          const bf16_t* vp = VtC + (et * 32 + r) * 68 + u * 32 + s * 16 + hh * 4; \
          const bf16x8 va = cat2(*(const u32x2*)vp, *(const u32x2*)(vp + 8)); \
          o[et] = MFMA32(va, pb, o[et]); \
        } \
      } \
    __builtin_amdgcn_s_setprio(0); \
    LDS_BARRIER(); \
  } while (0)
DI void diff_item(const Params& p, int l, int b, int h, int qblk, char* lds) {
  int tid = threadIdx.x; asm volatile("" : "+v"(tid)); const int lane = tid & 63, w = tid >> 6, qg = w >> 1, comp = w & 1, r = lane & 31, hh = lane >> 5;
  bf16_t* Ks = (bf16_t*)lds; bf16_t* Vt = Ks + 64 * 136;
  const bf16_t* Pb = p.P_() + (size_t)(b * S_) * NP;
  bf16x8 qf[4];
  {
    const bf16_t* qp = Pb + (size_t)(qblk * 128 + qg * 32 + r) * NP + BQ + h * 128 + comp * 64 + hh * 8;
#pragma unroll
    for (int ks = 0; ks < 4; ++ks) qf[ks] = *(const bf16x8*)(qp + ks * 16);
  }
  f32x16 o[4]; o[0] = zero16(); o[1] = zero16(); o[2] = zero16(); o[3] = zero16();
  float m = 0.f, lsum = 0.f;
  f32x16 negm = zero16();
  u32x4 krA[2], vrA[2], krB[2], vrB[2];
  const int krow_ = tid >> 4, kc = (tid & 15) * 8, kg2 = tid & 31, ec = tid >> 5;
#pragma unroll
  for (int i = 0; i < 2; ++i) {
    krA[i] = *(const u32x4*)(Pb + (size_t)(krow_ + 32 * i) * NP + BKc + h * 128 + kc);
    vrA[i] = *(const u32x4*)(Pb + (size_t)(2 * kg2 + i) * NP + BV + h * 128 + ec * 8);
    krB[i] = *(const u32x4*)(Pb + (size_t)(64 + krow_ + 32 * i) * NP + BKc + h * 128 + kc);
    vrB[i] = *(const u32x4*)(Pb + (size_t)(64 + 2 * kg2 + i) * NP + BV + h * 128 + ec * 8);
  }
#pragma unroll
  for (int i = 0; i < 2; ++i) *(u32x4*)(Ks + (krow_ + 32 * i) * 136 + kc) = krA[i];
#pragma unroll
  for (int wd = 0; wd < 4; ++wd) {
    const unsigned a = vrA[0][wd], c = vrA[1][wd];
    *(unsigned*)(Vt + (ec * 8 + 2 * wd) * 68 + 2 * kg2) = (a & 0xffffu) | (c << 16);
    *(unsigned*)(Vt + (ec * 8 + 2 * wd + 1) * 68 + 2 * kg2) = (a >> 16) | (c & 0xffff0000u);
  }
#pragma unroll
  for (int i = 0; i < 2; ++i) {
    krA[i] = *(const u32x4*)(Pb + (size_t)(128 + krow_ + 32 * i) * NP + BKc + h * 128 + kc);
    vrA[i] = *(const u32x4*)(Pb + (size_t)(128 + 2 * kg2 + i) * NP + BV + h * 128 + ec * 8);
  }
  LDS_BARRIER();
#pragma unroll 1
  for (int jt = 0; jt < 32; jt += 2) {
    DIFF_STEP(krB, vrB, jt, 0);
    DIFF_STEP(krA, vrA, jt + 1, 1);
  }
  __syncthreads();
  const float lt = lsum + __shfl_xor(lsum, 32), inv = 1.f / lt;
  const float lam = p.scal_()[l], li = p.scal_()[4 + l];
  __syncthreads();
  float* cmb = (float*)lds;
  if (comp == 1) {
    const float f = lam * inv;
#pragma unroll
    for (int et = 0; et < 4; ++et)
#pragma unroll
      for (int i = 0; i < 16; ++i) cmb[(qg * 128 + et * 32 + crow(i, hh)) * 32 + r] = o[et][i] * f;
  }
  __syncthreads();
  if (comp == 0) {
    float ss = 0.f;
#pragma unroll
    for (int et = 0; et < 4; ++et)
#pragma unroll
      for (int i = 0; i < 16; ++i) { const float v = o[et][i] * inv - cmb[(qg * 128 + et * 32 + crow(i, hh)) * 32 + r]; o[et][i] = v; ss += v * v; }
    ss += __shfl_xor(ss, 32);
    const float sc = rsqrtf(ss * (1.f / 128.f) + EPS) * (1.f - li);
    const size_t t = (size_t)b * S_ + qblk * 128 + qg * 32 + r;
#pragma unroll
    for (int et = 0; et < 4; ++et)
#pragma unroll
      for (int g4 = 0; g4 < 4; ++g4) {
        const int e = et * 32 + 8 * g4 + 4 * hh;
        const u32x2 gv = *(const u32x2*)(p.P_() + t * NP + BG + h * 128 + e);
        const f32x4 gn = *(const f32x4*)(p.diff_norm_g + l * 128 + e);
        const float y0 = o[et][4 * g4] * sc * gn[0] * siluf(bflo(gv[0])), y1 = o[et][4 * g4 + 1] * sc * gn[1] * siluf(bfhi(gv[0]));
        const float y2 = o[et][4 * g4 + 2] * sc * gn[2] * siluf(bflo(gv[1])), y3 = o[et][4 * g4 + 3] * sc * gn[3] * siluf(bfhi(gv[1]));
        u32x2 ov = {pk2(y0, y1), pk2(y2, y3)};
        *(u32x2*)(p.Y_() + ((size_t)T_ + t) * 512 + h * 128 + e) = ov;
      }
  }
}

template <int G>
DI void dil_item(const Params& p, int item, char* lds) {
  int tid = threadIdx.x; asm volatile("" : "+v"(tid)); const int lane = tid & 63, w = tid >> 6, a = lane & 31, hh = lane >> 5;
  constexpr int sh = 2 * G, D = 1 << sh, Sr = S_ >> sh, NROWS = G < 2 ? 384 : 256, VP = 388;
  const int b = item >> 6, h = (item >> 3) & 7, sub = item & 7;
  bf16_t* Ks = (bf16_t*)lds;
  bf16_t* Vt = Ks + 384 * 72;
  const bf16_t* Pb = p.P_() + (size_t)(b * S_) * NP;
  const int cls0 = G < 2 ? (sub & (D - 1)) : sub * 2;
  const int big = G < 2 ? (sub >> sh) : 0;
  const int R0 = G < 2 ? big * 256 - 64 : 0;
  const int c_w = G < 2 ? cls0 : cls0 + (w >> 2);
  const int blk = G < 2 ? big * 8 + w : (w & 3);
  const int iq = blk * 32 + a, tokl = (iq << sh) + c_w;
  bf16x8 qf[4];
  {
    const bf16_t* qp = Pb + (size_t)tokl * NP + CQ + h * 64 + hh * 8;
#pragma unroll
    for (int ks = 0; ks < 4; ++ks) qf[ks] = *(const bf16x8*)(qp + ks * 16);
  }
  {
    constexpr int NKP = NROWS * 8 / 512, NVU = (NROWS / 4 * 8 + 511) / 512;
    u32x4 kr[NKP]; u32x4 vr[NVU][4];
#pragma unroll
    for (int i = 0; i < NKP; ++i) {
      const int piece = tid + 512 * i, rl = piece >> 3, c8 = piece & 7;
      int idx = G < 2 ? R0 + rl : (rl & 127); idx = idx < 0 ? 0 : (idx >= Sr ? Sr - 1 : idx);
      const int cls = G < 2 ? cls0 : cls0 + (rl >> 7);
      kr[i] = *(const u32x4*)(Pb + (size_t)((idx << sh) + cls) * NP + CK + h * 64 + c8 * 8);
    }
#pragma unroll
    for (int j = 0; j < NVU; ++j) {
      const int wu = tid + 512 * j, rg = wu >> 3, ec = wu & 7;
      if (wu < NROWS / 4 * 8) {
#pragma unroll
        for (int i = 0; i < 4; ++i) {
          const int rl = 4 * rg + i;
          int idx = G < 2 ? R0 + rl : (rl & 127); idx = idx < 0 ? 0 : (idx >= Sr ? Sr - 1 : idx);
          const int cls = G < 2 ? cls0 : cls0 + (rl >> 7);
          vr[j][i] = *(const u32x4*)(Pb + (size_t)((idx << sh) + cls) * NP + CV + h * 64 + ec * 8);
        }
      }
    }
#pragma unroll
    for (int i = 0; i < NKP; ++i) { const int piece = tid + 512 * i; *(u32x4*)(Ks + (piece >> 3) * 72 + (piece & 7) * 8) = kr[i]; }
#pragma unroll
    for (int j = 0; j < NVU; ++j) {
      const int wu = tid + 512 * j, rg = wu >> 3, ec = wu & 7;
      if (wu < NROWS / 4 * 8) {
        u32x2 tv[8]; tr4x8(vr[j][0], vr[j][1], vr[j][2], vr[j][3], tv);
#pragma unroll
        for (int x = 0; x < 8; ++x) *(u32x2*)(Vt + (ec * 8 + x) * VP + 4 * rg) = tv[x];
      }
    }
  }
  __syncthreads();
  f32x16 o[2]; o[0] = zero16(); o[1] = zero16();
  float m = -30000.f, lsum = 0.f;
#pragma unroll 1
  for (int j = 0; j < 5; ++j) {
    const int i0 = blk * 32 - 64 + 32 * j;
    if (i0 < 0 || i0 >= Sr) continue;
    const int rl0 = G < 2 ? w * 32 + 32 * j : (w >> 2) * 128 + i0;
    f32x16 st = zero16();
#pragma unroll
    for (int ks = 0; ks < 4; ++ks) { const bf16x8 kf = *(const bf16x8*)(Ks + (rl0 + a) * 72 + ks * 16 + hh * 8); st = MFMA32(kf, qf[ks], st); }
    float mx = -1e30f;
#pragma unroll
    for (int i = 0; i < 16; ++i) {
      const int dlt = i0 + crow(i, hh) - iq;
      const bool ok = (dlt <= 64) && (dlt >= -64);
      st[i] = ok ? st[i] : -1e30f;
      mx = fmaxf(mx, st[i]);
    }
    mx = fmaxf(mx, __shfl_xor(mx, 32));
    const float mn = fmaxf(m, mx), alpha = ex2(m - mn);
    m = mn;
    float ps = 0.f;
#pragma unroll
    for (int i = 0; i < 16; ++i) { st[i] = ex2(st[i] - mn); ps += st[i]; }
    lsum = lsum * alpha + ps;
#pragma unroll
    for (int i = 0; i < 16; ++i) { o[0][i] *= alpha; o[1][i] *= alpha; }
#pragma unroll
    for (int s = 0; s < 2; ++s) {
      const bf16x8 pb = pack_step(st, s);
#pragma unroll
      for (int et = 0; et < 2; ++et) {
        const bf16_t* vp = Vt + (et * 32 + a) * VP + rl0 + s * 16 + hh * 4;
        const bf16x8 va = cat2(*(const u32x2*)vp, *(const u32x2*)(vp + 8));
        o[et] = MFMA32(va, pb, o[et]);
      }
    }
  }
  const float lt = lsum + __shfl_xor(lsum, 32), inv = 1.f / lt;
  const float lse = m + __log2f(lt);
  const size_t t = (size_t)b * S_ + tokl;
  if (G < 2) {
    bf16_t* pp = (bf16_t*)p.out + ((size_t)G * T_ + t) * 512 + h * 64;
    if (hh == 0) p.LSE_()[((size_t)G * T_ + t) * 8 + h] = lse;
#pragma unroll
    for (int et = 0; et < 2; ++et)
#pragma unroll
      for (int g4 = 0; g4 < 4; ++g4) {
        u32x2 ov = {pk2(o[et][4 * g4] * inv, o[et][4 * g4 + 1] * inv), pk2(o[et][4 * g4 + 2] * inv, o[et][4 * g4 + 3] * inv)};
        *(u32x2*)(pp + et * 32 + 8 * g4 + 4 * hh) = ov;
      }
  } else {
    const float l0 = p.LSE_()[t * 8 + h], l1 = p.LSE_()[((size_t)T_ + t) * 8 + h];
    const float mxl = fmaxf(fmaxf(l0, l1), lse);
    const float w0 = ex2(l0 - mxl), w1 = ex2(l1 - mxl), w2 = ex2(lse - mxl), rd = 1.f / (w0 + w1 + w2);
    const float f0 = w0 * rd, f1 = w1 * rd, f2 = w2 * rd * inv;
    const bf16_t* p0 = (const bf16_t*)p.out + t * 512 + h * 64;
    const bf16_t* p1 = (const bf16_t*)p.out + ((size_t)T_ + t) * 512 + h * 64;
#pragma unroll
    for (int et = 0; et < 2; ++et)
#pragma unroll
      for (int g4 = 0; g4 < 4; ++g4) {
        const int e = et * 32 + 8 * g4 + 4 * hh;
        const u32x2 a0 = *(const u32x2*)(p0 + e), a1 = *(const u32x2*)(p1 + e);
        const u32x2 gv = *(const u32x2*)(p.P_() + t * NP + CG + h * 64 + e);
        const float y0 = (o[et][4 * g4] * f2 + bflo(a0[0]) * f0 + bflo(a1[0]) * f1) * siluf(bflo(gv[0]));
        const float y1 = (o[et][4 * g4 + 1] * f2 + bfhi(a0[0]) * f0 + bfhi(a1[0]) * f1) * siluf(bfhi(gv[0]));
        const float y2 = (o[et][4 * g4 + 2] * f2 + bflo(a0[1]) * f0 + bflo(a1[1]) * f1) * siluf(bflo(gv[1]));
        const float y3 = (o[et][4 * g4 + 3] * f2 + bfhi(a0[1]) * f0 + bfhi(a1[1]) * f1) * siluf(bfhi(gv[1]));
        u32x2 ov = {pk2(y0, y1), pk2(y2, y3)};
        *(u32x2*)(p.Y_() + ((size_t)2 * T_ + t) * 512 + h * 64 + e) = ov;
      }
  }
}

DI void gla_pass1(const Params& p, int l, int it2, char* lds) {
  int tidf = threadIdx.x; asm volatile("" : "+v"(tidf));
  const int half = tidf >> 8, it = it2 * 2 + half, tid = tidf & 255, lane = tid & 63, w = tid >> 6, r = lane & 31, hh = lane >> 5;
  const int b = it >> 7, h = (it >> 5) & 3, m = it & 31;
  const size_t tok0 = (size_t)b * S_ + 64 * m;
  char* ldsh = lds + half * GLA_HALF;
  float* Bf = (float*)ldsh;
  bf16_t* Qh = (bf16_t*)(ldsh + 16640);
  bf16_t* Kh = Qh + 64 * 72;
  bf16_t* KeT = Kh + 64 * 72;
  bf16_t* Vt = KeT + 64 * 72;
  float* dec = (float*)(Vt + 128 * 68);
  float* lrs = (float*)Qh;
  const int cg_ = tid & 15, dc = (tid >> 4) & 7, ec = tid >> 4;
  const int e_w = 32 * w + r, dcol = tid & 63, cq = tid >> 6;
  u32x4 qk[4];
  {
    u32x4 vv[4];
#pragma unroll
    for (int i = 0; i < 4; ++i) {
      const size_t tok1 = tok0 + 4 * cg_ + i;
      qk[i] = *(const u32x4*)(p.P_() + tok1 * NP + (tid < 128 ? AK : AQ) + h * 64 + dc * 8);
      vv[i] = *(const u32x4*)(p.P_() + tok1 * NP + AV + h * 128 + ec * 8);
    }
    u32x2 tv[8]; tr4x8(vv[0], vv[1], vv[2], vv[3], tv);
#pragma unroll
    for (int x = 0; x < 8; ++x) *(u32x2*)(Vt + (ec * 8 + x) * 68 + 4 * cg_) = tv[x];
  }
  f32x16 o0 = zero16(), o1 = zero16();
#pragma unroll
  for (int dir = 0; dir < 2; ++dir) {
  float up[16];
#pragma unroll
  for (int i = 0; i < 16; ++i) up[i] = p.gate_up[((size_t)(l * 2 + dir) * 16 + i) * 256 + h * 64 + dcol];
  const float bias = p.gate_b[(l * 2 + dir) * 256 + h * 64 + dcol];
  {
    const int c2 = tid >> 2;
    const u32x2 lv = *(const u32x2*)(p.P_() + (tok0 + c2) * NP + LF + dir * 16 + (tid & 3) * 4);
    f32x4 lf = {bflo(lv[0]), bfhi(lv[0]), bflo(lv[1]), bfhi(lv[1])};
    *(f32x4*)(lrs + c2 * 16 + (tid & 3) * 4) = lf;
  }
  __syncthreads();
#pragma unroll 4
  for (int i = 0; i < 16; ++i) {
    const int c = cq * 16 + i;
    float z = bias;
#pragma unroll
    for (int q4 = 0; q4 < 4; ++q4) {
      const f32x4 lv = *(const f32x4*)(lrs + c * 16 + q4 * 4);
      z += lv[0] * up[4 * q4] + lv[1] * up[4 * q4 + 1] + lv[2] * up[4 * q4 + 2] + lv[3] * up[4 * q4 + 3];
    }
    Bf[c * 65 + dcol] = logsig(z) * (1.f / 16.f);
  }
  __syncthreads();
  if (tid < 64) {
    float acc = 0.f;
#pragma unroll 1
    for (int c0 = 0; c0 < 64; c0 += 8) {
      float v[8];
#pragma unroll
      for (int j = 0; j < 8; ++j) { const int c = dir ? 63 - (c0 + j) : c0 + j; v[j] = Bf[c * 65 + tid]; }
#pragma unroll
      for (int j = 0; j < 8; ++j) { const int c = dir ? 63 - (c0 + j) : c0 + j; acc += v[j]; Bf[c * 65 + tid] = acc; }
    }
  }
  __syncthreads();
  {
    const int CL = dir ? 0 : 63;
    float bl[8];
#pragma unroll
    for (int x = 0; x < 8; ++x) bl[x] = Bf[CL * 65 + dc * 8 + x];
    if (tid < 128) {
      float ke[4][8];
#pragma unroll
      for (int i = 0; i < 4; ++i) {
        const int c = 4 * cg_ + i;
        float kv[8] = {bflo(qk[i][0]), bfhi(qk[i][0]), bflo(qk[i][1]), bfhi(qk[i][1]), bflo(qk[i][2]), bfhi(qk[i][2]), bflo(qk[i][3]), bfhi(qk[i][3])};
        float kh[8];
#pragma unroll
        for (int x = 0; x < 8; ++x) { const float bb = Bf[c * 65 + dc * 8 + x]; kh[x] = kv[x] * __expf(-bb); ke[i][x] = kv[x] * __expf(bl[x] - bb); }
        u32x4 o = {pk2(kh[0], kh[1]), pk2(kh[2], kh[3]), pk2(kh[4], kh[5]), pk2(kh[6], kh[7])};
        *(u32x4*)(Kh + c * 72 + dc * 8) = o;
      }
#pragma unroll
      for (int x = 0; x < 8; ++x) {
        u32x2 o = {pk2(ke[0][x], ke[1][x]), pk2(ke[2][x], ke[3][x])};
        *(u32x2*)(KeT + (dc * 8 + x) * 72 + 4 * cg_) = o;
      }
      if (cg_ == 0) {
#pragma unroll
        for (int x = 0; x < 8; ++x) { const float dv = __expf(bl[x]); dec[dc * 8 + x] = dv; p.DEC_()[((size_t)(dir * 1024 + it)) * 64 + dc * 8 + x] = dv; }
      }
    } else {
#pragma unroll
      for (int i = 0; i < 4; ++i) {
        const int c = 4 * cg_ + i;
        float qv[8] = {bflo(qk[i][0]), bfhi(qk[i][0]), bflo(qk[i][1]), bfhi(qk[i][1]), bflo(qk[i][2]), bfhi(qk[i][2]), bflo(qk[i][3]), bfhi(qk[i][3])};
#pragma unroll
        for (int x = 0; x < 8; ++x) qv[x] *= __expf(Bf[c * 65 + dc * 8 + x]);
        u32x4 o = {pk2(qv[0], qv[1]), pk2(qv[2], qv[3]), pk2(qv[4], qv[5]), pk2(qv[6], qv[7])};
        *(u32x4*)(Qh + c * 72 + dc * 8) = o;
        *(u32x4*)(p.QH_() + ((size_t)(dir * 1024 + it) * 64 + c) * 64 + dc * 8) = o;
      }
    }
  }
  __syncthreads();
  f32x16 aD0 = zero16(), aD1 = zero16(), aX = zero16();
#pragma unroll
  for (int ks = 0; ks < 4; ++ks) {
    const bf16x8 kf0 = *(const bf16x8*)(Kh + r * 72 + ks * 16 + hh * 8), kf1 = *(const bf16x8*)(Kh + (32 + r) * 72 + ks * 16 + hh * 8);
    const bf16x8 qf0 = *(const bf16x8*)(Qh + r * 72 + ks * 16 + hh * 8), qf1 = *(const bf16x8*)(Qh + (32 + r) * 72 + ks * 16 + hh * 8);
    aD0 = MFMA32(kf0, qf0, aD0); aD1 = MFMA32(kf1, qf1, aD1);
    const bf16x8 kx = dir ? kf1 : kf0, qx = dir ? qf0 : qf1;
    aX = MFMA32(kx, qx, aX);
  }
#pragma unroll
  for (int i = 0; i < 16; ++i) { const bool keep = dir ? (crow(i, hh) >= r) : (crow(i, hh) <= r); aD0[i] = keep ? aD0[i] : 0.f; aD1[i] = keep ? aD1[i] : 0.f; }
  const bf16_t* vrow = Vt + e_w * 68;
#pragma unroll
  for (int s = 0; s < 2; ++s) {
    const bf16x8 vb0 = cat2(*(const u32x2*)(vrow + s * 16 + hh * 4), *(const u32x2*)(vrow + s * 16 + hh * 4 + 8));
    const bf16x8 vb1 = cat2(*(const u32x2*)(vrow + 32 + s * 16 + hh * 4), *(const u32x2*)(vrow + 32 + s * 16 + hh * 4 + 8));
    o0 = MFMA32(pack_step(aD0, s), vb0, o0);
    o1 = MFMA32(pack_step(aD1, s), vb1, o1);
    const bf16x8 px = pack_step(aX, s);
    if (dir == 0) o1 = MFMA32(px, vb0, o1); else o0 = MFMA32(px, vb1, o0);
  }
  f32x16 S0 = zero16(), S1 = zero16();
#pragma unroll
  for (int ks = 0; ks < 4; ++ks) {
    const bf16x8 vbn = cat2(*(const u32x2*)(vrow + ks * 16 + hh * 8), *(const u32x2*)(vrow + ks * 16 + hh * 8 + 4));
    const bf16x8 ka0 = *(const bf16x8*)(KeT + r * 72 + ks * 16 + hh * 8), ka1 = *(const bf16x8*)(KeT + (32 + r) * 72 + ks * 16 + hh * 8);
    S0 = MFMA32(ka0, vbn, S0); S1 = MFMA32(ka1, vbn, S1);
  }
  {
    bf16_t* up_ = p.UT_() + ((size_t)(dir * 1024 + it) * 128 + e_w) * 64;
#pragma unroll
    for (int g4 = 0; g4 < 4; ++g4) {
      u32x2 v0 = {pk2(S0[4 * g4], S0[4 * g4 + 1]), pk2(S0[4 * g4 + 2], S0[4 * g4 + 3])};
      u32x2 v1 = {pk2(S1[4 * g4], S1[4 * g4 + 1]), pk2(S1[4 * g4 + 2], S1[4 * g4 + 3])};
      *(u32x2*)(up_ + 8 * g4 + 4 * hh) = v0; *(u32x2*)(up_ + 32 + 8 * g4 + 4 * hh) = v1;
    }
  }
  __syncthreads();
  }
#pragma unroll
  for (int i = 0; i < 16; ++i) {
    p.OA_()[(tok0 + crow(i, hh)) * 512 + h * 128 + e_w] = o0[i];
    p.OA_()[(tok0 + 32 + crow(i, hh)) * 512 + h * 128 + e_w] = o1[i];
  }
}

DI void gla_scan(const Params& p) {
  int tid = threadIdx.x; asm volatile("" : "+v"(tid));
  for (int g = blockIdx.x * NT + tid; g < 65536; g += gridDim.x * NT) {
    const int dir = g >> 15, bh = (g >> 10) & 31, ch = g & 1023, d0 = (ch * 8) & 63;
    float st[8];
#pragma unroll
    for (int x = 0; x < 8; ++x) st[x] = 0.f;
#pragma unroll 8
    for (int step = 0; step < 32; ++step) {
      const int m = dir ? 31 - step : step, it = bh * 32 + m;
      bf16_t* ptr = p.UT_() + (size_t)(dir * 1024 + it) * 8192 + ch * 8;
      const u32x4 u = *(const u32x4*)ptr;
      const float* dp = p.DEC_() + (size_t)(dir * 1024 + it) * 64 + d0;
      const f32x4 da = *(const f32x4*)dp, db = *(const f32x4*)(dp + 4);
      u32x4 o = {pk2(st[0], st[1]), pk2(st[2], st[3]), pk2(st[4], st[5]), pk2(st[6], st[7])};
      *(u32x4*)ptr = o;
      st[0] = da[0] * st[0] + bflo(u[0]); st[1] = da[1] * st[1] + bfhi(u[0]); st[2] = da[2] * st[2] + bflo(u[1]); st[3] = da[3] * st[3] + bfhi(u[1]);
      st[4] = db[0] * st[4] + bflo(u[2]); st[5] = db[1] * st[5] + bfhi(u[2]); st[6] = db[2] * st[6] + bflo(u[3]); st[7] = db[3] * st[7] + bfhi(u[3]);
    }
  }
}

DI void gla_pass3(const Params& p, int l, int it2, char* lds) {
  int tidf = threadIdx.x; asm volatile("" : "+v"(tidf));
  const int half = tidf >> 8, tid = tidf & 255, lane = tid & 63, w = tid >> 6, r = lane & 31, hh = lane >> 5;
  const int it = it2 * 2 + half;
  const int b = it >> 7, h = (it >> 5) & 3, m = it & 31;
  const size_t tok0 = (size_t)b * S_ + 64 * m;
  float* ot = (float*)(lds + half * 34816);
  f32x16 o0, o1;
#pragma unroll
  for (int i = 0; i < 16; ++i) {
    o0[i] = p.OA_()[(tok0 + crow(i, hh)) * 512 + h * 128 + 32 * w + r];
    o1[i] = p.OA_()[(tok0 + 32 + crow(i, hh)) * 512 + h * 128 + 32 * w + r];
  }
#pragma unroll
  for (int dir = 0; dir < 2; ++dir) {
    const bf16_t* qb = p.QH_() + (size_t)(dir * 1024 + it) * 4096;
    const bf16_t* sbp = p.UT_() + ((size_t)(dir * 1024 + it) * 128 + 32 * w + r) * 64;
#pragma unroll
    for (int ks = 0; ks < 4; ++ks) {
      const bf16x8 qa0 = *(const bf16x8*)(qb + r * 64 + ks * 16 + hh * 8), qa1 = *(const bf16x8*)(qb + (32 + r) * 64 + ks * 16 + hh * 8);
      const bf16x8 sv = *(const bf16x8*)(sbp + ks * 16 + hh * 8);
      o0 = MFMA32(qa0, sv, o0); o1 = MFMA32(qa1, sv, o1);
    }
  }
#pragma unroll
  for (int i = 0; i < 16; ++i) { ot[crow(i, hh) * 132 + 32 * w + r] = o0[i]; ot[(32 + crow(i, hh)) * 132 + 32 * w + r] = o1[i]; }
  unsigned gvv[16];
#pragma unroll
  for (int k = 0; k < 16; ++k) gvv[k] = *(const unsigned*)(p.P_() + (tok0 + w * 16 + k) * NP + AG + h * 128 + 2 * lane);
  __syncthreads();
  float* ssq = ot + 64 * 132;
  {
    const int c = tid & 63, q = tid >> 6;
    float part = 0.f;
#pragma unroll
    for (int j = 0; j < 8; ++j) { const f32x4 v = *(const f32x4*)(ot + c * 132 + 32 * q + 4 * j); part += (v[0] * v[0] + v[1] * v[1]) + (v[2] * v[2] + v[3] * v[3]); }
    ssq[q * 64 + c] = part;
  }
  __syncthreads();
  const f32x2 gn = *(const f32x2*)(p.gla_norm_g + l * 128 + 2 * lane);
#pragma unroll
  for (int k = 0; k < 16; ++k) {
    const int c = w * 16 + k;
    const size_t tok = tok0 + c;
    const f32x2 v = *(const f32x2*)(ot + c * 132 + 2 * lane);
    const float ss = (ssq[c] + ssq[64 + c]) + (ssq[128 + c] + ssq[192 + c]);
    const float sc = rsqrtf(ss * (1.f / 128.f) + EPS);
    const unsigned gv = gvv[k];
    *(unsigned*)(p.Y_() + tok * 512 + h * 128 + 2 * lane) = pk2(v[0] * sc * gn[0] * siluf(bflo(gv)), v[1] * sc * gn[1] * siluf(bfhi(gv)));
  }
}

template <int ONLY> DI void phase_m1(const Params& p, int l, char* lds) {
  for (int id = blockIdx.x; id < 2048; id += gridDim.x) {
    if (id < 512) {
      const int c = id & 255, k = id >> 8, xcd = c & 7, slot = c >> 3, bh = xcd * 4 + (slot >> 3), qblk = (slot & 7) + 8 * k;
      if (ONLY == 0 || ONLY == 1) diff_item(p, l, bh >> 2, bh & 3, qblk, lds);
    }
    else if (id < 1024) { if (ONLY == 0 || ONLY == 2) gla_pass1(p, l, id - 512, lds); }
    else if (id < 1536) { if (ONLY == 0 || ONLY == 3) dil_item<0>(p, id - 1024, lds); }
    else { if (ONLY == 0 || ONLY == 3) dil_item<1>(p, id - 1536, lds); }
    __syncthreads();
  }
}
DI void phase_m3(const Params& p, int l, char* lds) {
  for (int id = blockIdx.x; id < 1024; id += gridDim.x) {
    if (id < 512) dil_item<2>(p, id, lds);
    else gla_pass3(p, l, id - 512, lds);
    __syncthreads();
  }
}

DI void phase_final(const Params& p) {
  int tid = threadIdx.x; asm volatile("" : "+v"(tid)); const int lane = tid & 63;
  const int gw = (blockIdx.x * NT + tid) >> 6, nw = gridDim.x * (NT / 64);
  const float* SSl = p.SS_() + (size_t)4 * T_ * 16;
  for (int t = gw; t < T_; t += nw) {
    const float rs = row_rs(SSl, t);
#pragma unroll
    for (int i = 0; i < 4; ++i) {
      const u32x2 xb = *(const u32x2*)(p.XB_() + (size_t)t * DM + i * 256 + lane * 4);
      const f32x4 g = *(const f32x4*)(p.final_g + i * 256 + lane * 4);
      f32x4 v = {bflo(xb[0]) * rs * g[0], bfhi(xb[0]) * rs * g[1], bflo(xb[1]) * rs * g[2], bfhi(xb[1]) * rs * g[3]};
      *(f32x4*)(p.out + (size_t)t * DM + i * 256 + lane * 4) = v;
    }
  }
}

#if DEBUG_CHECK
DI unsigned hsh(unsigned x) { x ^= x >> 16; x *= 0x7feb352du; x ^= x >> 15; x *= 0x846ca68bu; x ^= x >> 16; return x; }
DI void flag_err(const Params& p, int stage, float got, float ref, float tol) {
  const float e = fabsf(got - ref);
  atomicAdd(p.cnt_() + 16 + stage, 1);
  if (!(e <= tol * fabsf(ref) + tol)) atomicAdd(p.cnt_() + 32 + stage, 1);
}
DI void chk_weights(const Params& p) {
  const int gt = blockIdx.x * NT + threadIdx.x;
  if (gt >= 2048) return;
  const unsigned hv = hsh(gt * 3u + 1u);
  const int l = hv & 3, k = (hv >> 2) & 1023; int n = (hv >> 12) % NP;
  if (gt < 64) n = LF - 8 + gt;
  const int col = win_col(n); const float cs = win_scale(n);
  const float ref = col < 0 ? 0.f : p.w_in[((size_t)l * 1024 + k) * 8736 + col] * p.norm_g[l * 1024 + k] * cs;
  flag_err(p, 1, bf2f(p.Wi_()[((size_t)l * NP + n) * 1024 + k]), ref, 0.01f);
  const int g = hv % 3, kb = (hv >> 5) & 511, nb = (hv >> 14) & 1023;
  flag_err(p, 1, bf2f(p.Wb_()[((size_t)(l * 3 + g) * 1024 + nb) * 512 + kb]), p.w_branch[(((size_t)(l * 3 + g)) * 512 + kb) * 1024 + nb], 0.01f);
  flag_err(p, 1, bf2f(p.Wo_()[((size_t)l * 1024 + nb) * 1024 + k]), p.w_out[((size_t)l * 1024 + k) * 1024 + nb], 0.01f);
}
DI float chk_proj_raw(const Params& p, int l, int t, int n) {
  const int col = n < 1536 ? n : (n < LF ? n + 32 : (n < LF + 32 ? n - LF + 1536 : -1));
  if (col < 0) return 0.f;
  float s = 0.f;
  for (int k = 0; k < 1024; ++k) {
    const float wv = p.w_in[((size_t)l * 1024 + k) * 8736 + col] * p.norm_g[l * 1024 + k] * win_scale(n);
    s += bf2f(p.XB_()[(size_t)t * DM + k]) * bf2f((bf16_t)(pk2(wv, 0.f) & 0xffff));
  }
  return s * row_rs(p.SS_() + (size_t)l * T_ * 16, t);
}
DI void chk_inproj(const Params& p, int l) {
  const int gt = blockIdx.x * NT + threadIdx.x;
  if (gt >= 512) return;
  const unsigned hv = hsh(gt * 7u + 13u + l);
  const int t = hv & (T_ - 1); int n = (hv >> 14) % 8736;
  if (gt < 128) n = BQ + (hv >> 14) % 1024;
  else if (gt < 256) n = CQ + (hv >> 14) % 1024;
  float ref = chk_proj_raw(p, l, t, n);
  const bool rope = (n >= BQ && n < BV) || (n >= CQ && n < CV);
  if (rope) {
    const int d = n & 63, dd = d & 31;
    const float other = chk_proj_raw(p, l, t, d < 32 ? n + 32 : n - 32);
    const float ang = (float)(t & (S_ - 1)) * (1.0f / powf(10000.f, (float)(2 * dd) / 64.f));
    const float cs = cosf(ang), sn = sinf(ang);
    ref = d < 32 ? ref * cs - other * sn : ref * cs + other * sn;
  }
  flag_err(p, 2, bf2f(p.P_()[(size_t)t * NP + n]), ref, 0.03f);
}
DI void chk_gla(const Params& p, int l, char* lds) {
  if (blockIdx.x >= 16) return;
  int tid = threadIdx.x & 255; asm volatile("" : "+v"(tid));
  const unsigned hv = hsh(blockIdx.x * 11u + 5u + l);
  const int b = hv & 7, h = (hv >> 3) & 3;
  int t = (hv >> 5) & (S_ - 1);
  t = (blockIdx.x & 1) ? (t & 255) : (S_ - 1 - (t & 255));
  if (blockIdx.x < 4) t = (blockIdx.x & 1) ? 300 + (hv >> 20) % 200 : S_ - 1 - 300 - (hv >> 20) % 200;
  float* kq = (float*)lds;
  float* kk = kq; float* qq = kq + 64; float* aa = kq + 128; float* vv = kq + 192; float* red = kq + 320;
  const int e = tid & 127, dh = tid >> 7;
  float otot = 0.f;
  for (int dir = 0; dir < 2; ++dir) {
    float st[32];
#pragma unroll
    for (int i = 0; i < 32; ++i) st[i] = 0.f;
    const int nsteps = dir == 0 ? t + 1 : S_ - t;
    for (int s = 0; s < nsteps; ++s) {
      const int tau = dir == 0 ? s : S_ - 1 - s;
      const size_t tok = (size_t)b * S_ + tau;
      __syncthreads();
      if (tid < 64) {
        float z = p.gate_b[(l * 2 + dir) * 256 + h * 64 + tid];
        for (int rk = 0; rk < 16; ++rk) z += bf2f(p.P_()[tok * NP + LF + dir * 16 + rk]) * p.gate_up[((size_t)(l * 2 + dir) * 16 + rk) * 256 + h * 64 + tid];
        aa[tid] = expf(logsig(z) * (1.f / 16.f));
        kk[tid] = bf2f(p.P_()[tok * NP + AK + h * 64 + tid]);
        qq[tid] = bf2f(p.P_()[tok * NP + AQ + h * 64 + tid]);
      } else if (tid < 192) vv[tid - 64] = bf2f(p.P_()[tok * NP + AV + h * 128 + tid - 64]);
      __syncthreads();
      const float ve = vv[e];
#pragma unroll
      for (int i = 0; i < 32; ++i) st[i] = aa[dh * 32 + i] * st[i] + kk[dh * 32 + i] * ve;
    }
    float part = 0.f;
#pragma unroll
    for (int i = 0; i < 32; ++i) part += qq[dh * 32 + i] * st[i];
    otot += part;
  }
  __syncthreads();
  red[tid] = otot;
  __syncthreads();
  float oe = 0.f;
  if (tid < 128) { oe = red[tid] + red[tid + 128]; }
  __syncthreads();
  if (tid < 128) red[tid] = oe * oe;
  __syncthreads();
  if (tid == 0) { float s = 0.f; for (int i = 0; i < 128; ++i) s += red[i]; red[200] = s; }
  __syncthreads();
  if (tid < 128) {
    const size_t tok = (size_t)b * S_ + t;
    const float sc = rsqrtf(red[200] * (1.f / 128.f) + EPS);
    const float ref = oe * sc * p.gla_norm_g[l * 128 + tid] * siluf(bf2f(p.P_()[tok * NP + AG + h * 128 + tid]));
    flag_err(p, 3, bf2f(p.Y_()[tok * 512 + h * 128 + tid]), ref, 0.05f);
    { const float got = bf2f(p.Y_()[tok * 512 + h * 128 + tid]);
      if (!(fabsf(got - ref) <= 0.05f * fabsf(ref) + 0.05f)) atomicOr(p.cnt_() + 50, (1 << ((t >> 6) & 1)) | (4 << (blockIdx.x & 1))); }
  }
  __syncthreads();
}
DI void chk_diff(const Params& p, int l, char* lds) {
  if (blockIdx.x < 16 || blockIdx.x >= 48) return;
  int tid = threadIdx.x < 256 ? (int)threadIdx.x : 1000000; asm volatile("" : "+v"(tid));
  const bool act = tid < 256;
  const unsigned hv = hsh(blockIdx.x * 17u + 3u + l);
  const int b = hv & 7, h = (hv >> 3) & 3, q = (hv >> 5) & (S_ - 1);
  float* w0 = (float*)lds; float* w1 = w0 + 2048; float* red = w1 + 2048;
  const size_t tq = (size_t)b * S_ + q;
  float mx0 = -1e30f, mx1 = -1e30f;
  for (int k = tid; k < S_; k += 256) {
    const size_t tk = (size_t)b * S_ + k;
    float s0 = 0.f, s1 = 0.f;
    for (int d = 0; d < 64; ++d) {
      s0 += bf2f(p.P_()[tq * NP + BQ + h * 128 + d]) * bf2f(p.P_()[tk * NP + BKc + h * 128 + d]);
      s1 += bf2f(p.P_()[tq * NP + BQ + h * 128 + 64 + d]) * bf2f(p.P_()[tk * NP + BKc + h * 128 + 64 + d]);
    }
    w0[k] = s0; w1[k] = s1; mx0 = fmaxf(mx0, s0); mx1 = fmaxf(mx1, s1);
  }
  if (act) { red[tid] = mx0; red[256 + tid] = mx1; }
  __syncthreads();
  if (tid == 0) { float a = -1e30f, c = -1e30f; for (int i = 0; i < 256; ++i) { a = fmaxf(a, red[i]); c = fmaxf(c, red[256 + i]); } red[512] = a; red[513] = c; }
  __syncthreads();
  mx0 = red[512]; mx1 = red[513];
  float l0 = 0.f, l1 = 0.f;
  for (int k = tid; k < S_; k += 256) { const float a = exp2f(w0[k] - mx0), c = exp2f(w1[k] - mx1); w0[k] = a; w1[k] = c; l0 += a; l1 += c; }
  __syncthreads();
  if (act) { red[tid] = l0; red[256 + tid] = l1; }
  __syncthreads();
  if (tid == 0) { float a = 0.f, c = 0.f; for (int i = 0; i < 256; ++i) { a += red[i]; c += red[256 + i]; } red[514] = a; red[515] = c; }
  __syncthreads();
  l0 = red[514]; l1 = red[515];
  const float lam = p.scal_()[l], li = p.scal_()[4 + l];
  float oe = 0.f;
  if (tid < 128) {
    float a0 = 0.f, a1 = 0.f;
    for (int k = 0; k < S_; ++k) { const float v = bf2f(p.P_()[((size_t)b * S_ + k) * NP + BV + h * 128 + tid]); a0 += w0[k] * v; a1 += w1[k] * v; }
    oe = a0 / l0 - lam * a1 / l1;
  }
  __syncthreads();
  if (tid < 128) red[tid] = oe * oe;
  __syncthreads();
  if (tid == 0) { float s = 0.f; for (int i = 0; i < 128; ++i) s += red[i]; red[600] = s; }
  __syncthreads();
  if (tid < 128) {
    const float sc = rsqrtf(red[600] * (1.f / 128.f) + EPS) * (1.f - li);
    const float ref = oe * sc * p.diff_norm_g[l * 128 + tid] * siluf(bf2f(p.P_()[tq * NP + BG + h * 128 + tid]));
    flag_err(p, 4, bf2f(p.Y_()[((size_t)T_ + tq) * 512 + h * 128 + tid]), ref, 0.05f);
  }
  __syncthreads();
}
DI void chk_dil(const Params& p, int l) {
  const int gt = blockIdx.x * NT + threadIdx.x - 48 * NT;
  if (gt < 0 || gt >= 512) return;
  const unsigned hv = hsh(gt * 29u + 7u + l);
  const int b = hv & 7, h = (hv >> 3) & 7, e = (hv >> 6) & 63; int t = (hv >> 12) & (S_ - 1);
  if (gt < 64) t = gt & 1 ? (t & 127) : S_ - 1 - (t & 127);
  const size_t tq = (size_t)b * S_ + t;
  float num = 0.f, den = 0.f, mx = -1e30f;
  for (int pass = 0; pass < 2; ++pass)
    for (int g = 0; g < 3; ++g) {
      const int D = 1 << (2 * g);
      for (int j = -64; j <= 64; ++j) {
        const int tk = t + j * D;
        if (tk < 0 || tk >= S_) continue;
        const size_t tkk = (size_t)b * S_ + tk;
        float s = 0.f;
        for (int d = 0; d < 64; ++d) s += bf2f(p.P_()[tq * NP + CQ + h * 64 + d]) * bf2f(p.P_()[tkk * NP + CK + h * 64 + d]);
        if (pass == 0) mx = fmaxf(mx, s);
        else { const float w = exp2f(s - mx); den += w; num += w * bf2f(p.P_()[tkk * NP + CV + h * 64 + e]); }
      }
    }
  const float ref = num / den * siluf(bf2f(p.P_()[tq * NP + CG + h * 64 + e]));
  flag_err(p, 5, bf2f(p.Y_()[((size_t)2 * T_ + tq) * 512 + h * 64 + e]), ref, 0.05f);
}
DI void chk_merge(const Params& p, int l) {
  const int gt = blockIdx.x * NT + threadIdx.x;
  if (gt >= 512) return;
  const unsigned hv = hsh(gt * 31u + 9u + l);
  const int t = hv & (T_ - 1), n = (hv >> 14) & 1023;
  float ref = 0.f;
  for (int g = 0; g < 3; ++g) {
    float s = 0.f;
    for (int k = 0; k < 512; ++k) s += bf2f(p.Y_()[((size_t)g * T_ + t) * 512 + k]) * bf2f(p.Wb_()[((size_t)(l * 3 + g) * 1024 + n) * 512 + k]);
    ref += s / bf2f(p.P_()[(size_t)t * NP + MG + g * 1024 + n]);
  }
  flag_err(p, 6, bf2f(p.MIX_()[(size_t)t * DM + n]), ref, 0.03f);
}
DI void chk_out(const Params& p, int l, const float* Xold, const float* Xnew) {
  const int gt = blockIdx.x * NT + threadIdx.x;
  if (gt >= 512) return;
  const unsigned hv = hsh(gt * 37u + 11u + l);
  const int t = hv & (T_ - 1), n = (hv >> 14) & 1023;
  float s = 0.f;
  for (int k = 0; k < 1024; ++k) s += bf2f(p.MIX_()[(size_t)t * DM + k]) * bf2f(p.Wo_()[((size_t)l * 1024 + n) * 1024 + k]);
  flag_err(p, 7, Xnew[(size_t)t * DM + n], Xold[(size_t)t * DM + n] + s, 0.01f);
  if (gt < 64) {
    float ss = 0.f;
    for (int k = 0; k < 1024; ++k) { const float v = Xnew[(size_t)t * DM + k]; ss += v * v; }
    { const float* q = p.SS_() + ((size_t)(l + 1) * T_ + t) * 16; float tot = 0.f; for (int j = 0; j < 16; ++j) tot += q[j]; flag_err(p, 8, tot, ss, 0.001f); }
  }
}
#endif

#define GSYNC() do { asm volatile("s_waitcnt vmcnt(0) lgkmcnt(0)" ::: "memory"); grid.sync(); __builtin_amdgcn_fence(__ATOMIC_ACQUIRE, "agent"); asm volatile("s_waitcnt vmcnt(0)" ::: "memory"); __syncthreads(); } while (0)
#define XB_TMO      128
#define XB_XCNT(j)  (256  + 64 * (j))
#define XB_XSUB(j)  (1280 + 64 * (j))
#define XB_XGEN(j)  (2304 + 64 * (j))
#define XB_TOP      3328
#define XB_TOPGEN   3392
#define XCD_BAR_WORDS 3456
#define XB_SPIN_CAP (1u << 18)

__device__ __forceinline__ unsigned xb_ld(unsigned* p)              { return __hip_atomic_load(p, __ATOMIC_RELAXED, __HIP_MEMORY_SCOPE_AGENT); }
__device__ __forceinline__ unsigned xb_add(unsigned* p, unsigned v) { return __hip_atomic_fetch_add(p, v, __ATOMIC_RELAXED, __HIP_MEMORY_SCOPE_AGENT); }
__device__ __forceinline__ unsigned xb_xcc_id() { return (unsigned)__builtin_amdgcn_s_getreg((3 << 11) | 20) & 0xFu; }
#define XB_SPIN(cond, bar) do { unsigned _sp = 0; while (cond) { __builtin_amdgcn_s_sleep(1); \
    if ((++_sp & 255u) == 0u) { if (xb_ld(&(bar)[XB_TMO])) break; if (_sp > XB_SPIN_CAP) { atomicAdd(&(bar)[XB_TMO], 1u); break; } } } } while (0)

struct XcdBarrier {
    unsigned* bar; unsigned x;
    volatile PG8_LAS unsigned* st;
};

__device__ __forceinline__ XcdBarrier xcd_barrier_post(unsigned* bar, volatile PG8_LAS unsigned* st) {
    XcdBarrier b; b.bar = bar; b.x = xb_xcc_id(); b.st = st;
    if (threadIdx.x == 0) (void)xb_add(&bar[XB_XCNT(b.x)], 1u);
    return b;
}
__device__ __forceinline__ void xcd_barrier_complete(unsigned* bar, unsigned x, unsigned& nloc, unsigned& nx) {
    const unsigned G = gridDim.x * gridDim.y * gridDim.z;
    unsigned sum, cnt, mine, sp = 0u;
    for (;;) {
        sum = 0u; cnt = 0u; mine = 0u;
#pragma unroll
        for (unsigned j = 0; j < 16; ++j) { const unsigned c = xb_ld(&bar[XB_XCNT(j)]); sum += c; cnt += (c > 0u) ? 1u : 0u; mine = (j == x) ? c : mine; }
        if (sum == G) break;
        __builtin_amdgcn_s_sleep(1);
        if ((++sp & 255u) == 0u) { if (xb_ld(&bar[XB_TMO])) break; if (sp > XB_SPIN_CAP) { atomicAdd(&bar[XB_TMO], 1u); break; } }
    }
    nloc = mine > 0u ? mine : 1u; nx = cnt > 0u ? cnt : 1u;
}

__device__ __forceinline__ void xcd_barrier(const XcdBarrier& b) {
    asm volatile("s_waitcnt vmcnt(0)" ::: "memory");
    __syncthreads();
    if (threadIdx.x == 0) {
        unsigned* bar = b.bar;
        __builtin_amdgcn_s_waitcnt(0);
        unsigned nloc = b.st[0], nx = b.st[1];
        if (nloc == 0u) { xcd_barrier_complete(bar, b.x, nloc, nx); b.st[0] = nloc; b.st[1] = nx; }
        const unsigned old = xb_add(&bar[XB_XSUB(b.x)], 1u);
        const unsigned gen = old / nloc;
        if (old + 1u == (gen + 1u) * nloc) {
            __builtin_amdgcn_fence(__ATOMIC_RELEASE, "agent");
            asm volatile("s_waitcnt vmcnt(0)" ::: "memory");
            const unsigned og = xb_add(&bar[XB_TOP], 1u);
            const unsigned tg = og / nx;
            if (og + 1u == (tg + 1u) * nx) xb_add(&bar[XB_TOPGEN], 1u);
            else XB_SPIN(xb_ld(&bar[XB_TOPGEN]) == tg, bar);
            __builtin_amdgcn_fence(__ATOMIC_ACQUIRE, "agent");
            xb_add(&bar[XB_XGEN(b.x)], 1u);
            asm volatile("s_waitcnt vmcnt(0)" ::: "memory");
        } else {
            XB_SPIN(xb_ld(&bar[XB_XGEN(b.x)]) == gen, bar);
            __builtin_amdgcn_fence(__ATOMIC_ACQUIRE, "agent");
            asm volatile("s_waitcnt vmcnt(0)" ::: "memory");
        }
    }
    __syncthreads();
}
#define GBAR() do { XcdBarrier xb_ = xbar; unsigned xx_ = xb_.x; asm volatile("" : "+s"(xx_)); xb_.x = xx_; xcd_barrier(xb_); } while (0)
__global__ void __launch_bounds__(NT, 2) fwd_megakernel(Params p) {
  char* lds = g_lds;
  cg::grid_group grid = cg::this_grid();
  PG8_LAS unsigned char* lds3 = (PG8_LAS unsigned char*)lds;
  volatile PG8_LAS unsigned* xst = (volatile PG8_LAS unsigned*)(lds3 + ITEM_OFF);
  if (threadIdx.x == 0) { xst[0] = 0u; xst[1] = 0u; }
  __syncthreads();
  const XcdBarrier xbar = xcd_barrier_post((unsigned*)(p.ws + OFF_BAR), xst);
  prologue(p, lds);
  if (p.ws == nullptr) grid.sync();
  GBAR();
#if DEBUG_CHECK && DBG_W
  chk_weights(p);
#endif
  const float* Xold = p.x;
  for (int l = 0; l < DEPTH; ++l) {
    float* Xnew = p.out;
    {
      pg8::Gemm g{p.XB_(), p.Wi_() + (size_t)l * NP * 1024, T_, NP, 1024}; pg8::StaticOrder S; S.init(T_, NP, (int)gridDim.x, (int)blockIdx.x);
      {
        PG8_LAS float* rsT = (PG8_LAS float*)(lds3 + 131072);
        PG8_LAS int* ulist = (PG8_LAS int*)(lds3 + 131072 + 14336);
        int tid = threadIdx.x; asm volatile("" : "+v"(tid));
        const float* SSl = p.SS_() + (size_t)l * T_ * 16;
        if (tid < 16) { pg8::Unit u; u.pm = 0; u.pn = 0; const bool ok = tid < 14 && S.next(tid, u); ulist[tid] = ok ? ((u.pm << 8) | u.pn) : -1; }
        __syncthreads();
        for (int idx = tid; idx < 14 * 256; idx += NT) { const int key = ulist[idx >> 8]; if (key >= 0) rsT[idx] = row_rs(SSl, (key >> 8) * 256 + (idx & 255)); }
        __syncthreads();
      }
      EpiInproj E{p.P_()};
      pg8::gemm_phase<EpiInproj, pg8::StaticOrder, INPROJ_ALIGN, DBG_SP2>(lds3, g, S, E);
#if PROBE_REP == 5
      GBAR();
      pg8::gemm_phase<EpiInproj, pg8::StaticOrder, true, DBG_SP2>(lds3, g, S, E);
#endif
#if PROBE_REP == 8
      GBAR();
      { EpiNullProbe E2{p.scal_() + 32, p.scal_() + 16, p.SS_() + (size_t)l * T_ * 16}; pg8::gemm_phase<EpiNullProbe, pg8::StaticOrder, true, DBG_SP2>(lds3, g, S, E2); }
#endif
    }
    GBAR();
#if DEBUG_CHECK && DBG_IN
    chk_inproj(p, l);
#endif
    phase_m1<0>(p, l, lds);
#if PROBE_REP >= 1 && PROBE_REP <= 4
    GBAR();
    if (blockIdx.x == 0 && threadIdx.x == 0) p.cnt_()[l] = 0;
    GBAR();
    phase_m1<(PROBE_REP & 3)>(p, l, lds);
#endif
    GBAR();
    gla_scan(p);
    GBAR();
    phase_m3(p, l, lds);
#if PROBE_REP == 7
    GBAR(); GBAR(); GBAR(); GBAR(); GBAR(); GBAR(); GBAR(); GBAR();
#endif
#if PROBE_REP == 6
    GBAR();
    if (blockIdx.x == 0 && threadIdx.x == 0) p.cnt_()[4 + l] = 0;
    GBAR();
    phase_m3(p, l, lds);
#endif
    GBAR();
#if DEBUG_CHECK
#if DBG_GLA
    chk_gla(p, l, lds);
#endif
#if DBG_DIFF
    chk_diff(p, l, lds);
#endif
#if DBG_DIL
    chk_dil(p, l);
#endif
    __syncthreads();
#endif
    {
      pg8::Gemm g{p.Y_(), p.Wb_() + (size_t)l * 3 * 1024 * 512, 3 * T_, 3 * 1024, 512}; MergeOrder S{(int)gridDim.x, (int)blockIdx.x};
      EpiMerge E{p.P_(), p.MIX_()};
#ifndef NO_MERGE
      pg8::gemm_phase<EpiMerge, MergeOrder, true, DBG_SP2>(lds3, g, S, E);
#endif
    }
    GBAR();
#if DEBUG_CHECK && DBG_MERGE
    chk_merge(p, l);
#endif
    {
      pg8::Gemm g{p.MIX_(), p.Wo_() + (size_t)l * 1024 * 1024, T_, 1024, 1024}; pg8::StaticOrder S; S.init(T_, 1024, (int)gridDim.x, (int)blockIdx.x);
      EpiOut E{l == 0 ? p.x : nullptr, p.XB_(), p.SS_() + (size_t)(l + 1) * T_ * 16};
#ifndef NO_OUT
      pg8::gemm_phase<EpiOut, pg8::StaticOrder, true, DBG_SP2>(lds3, g, S, E);
#endif
    }
    GBAR();
#if DEBUG_CHECK
    GBAR();
#endif
    Xold = Xnew;
  }
  phase_final(p);
#if DEBUG_CHECK
  GBAR();
  if (blockIdx.x == 0 && threadIdx.x == 0) {
    for (int s = 1; s < 16; ++s) {
      const int tot = p.cnt_()[16 + s], bad = p.cnt_()[32 + s];
      if (bad > 0) { int dec = (bad * 10) / (tot > 0 ? tot : 1); if (dec > 9) dec = 9; p.out[0] = 1000.f * s + 100.f * dec;
        if (s == 3) p.out[0] = 100.f * (float)(1 + (p.cnt_()[50] & 15));
        break; }
    }
  }
#endif
}

extern "C" void kernel_launch(void* const* d_in, const int* in_sizes, int n_in, void* d_out, int out_size,
                              void* d_ws, size_t ws_size, hipStream_t stream) {
  static int grid_blocks = 0;
  if (!grid_blocks) {
    int dev = 0, cus = 0, per_cu = 0;
    (void)hipGetDevice(&dev);
    (void)hipDeviceGetAttribute(&cus, hipDeviceAttributeMultiprocessorCount, dev);
    if (hipFuncSetAttribute((const void*)fwd_megakernel, hipFuncAttributeMaxDynamicSharedMemorySize, LDS_BYTES) != hipSuccess) fprintf(stderr, "hipFuncSetAttribute(dynamic LDS) failed\n");
    (void)hipOccupancyMaxActiveBlocksPerMultiprocessor(&per_cu, fwd_megakernel, NT, LDS_BYTES);
    (void)hipGetLastError();
    grid_blocks = cus;
  }
  Params p{};
  p.x = (const float*)d_in[0]; p.norm_g = (const float*)d_in[1]; p.w_in = (const float*)d_in[2]; p.gate_up = (const float*)d_in[3];
  p.gate_b = (const float*)d_in[4]; p.gla_norm_g = (const float*)d_in[5]; p.diff_lambda = (const float*)d_in[6]; p.diff_norm_g = (const float*)d_in[7];
  p.w_branch = (const float*)d_in[8]; p.w_out = (const float*)d_in[9]; p.final_g = (const float*)d_in[10];
  p.out = (float*)d_out;
  p.ws = (char*)d_ws;
  if (WS_END > ws_size) { fprintf(stderr, "workspace too small: need %zu have %zu\n", (size_t)WS_END, ws_size); return; }
  if (hipMemsetAsync((char*)d_ws + OFF_BAR, 0, 16384, stream) != hipSuccess) { fprintf(stderr, "barrier memset failed\n"); return; }
  void* args[] = {&p};
  hipError_t e = hipLaunchCooperativeKernel((void*)fwd_megakernel, dim3(grid_blocks), dim3(NT), args, LDS_BYTES, stream);
  if (e != hipSuccess) fprintf(stderr, "cooperative launch failed: %s (grid %d)\n", hipGetErrorString(e), grid_blocks);
}
```

```cpp
#include <hip/hip_runtime.h>
#include <hip/hip_cooperative_groups.h>
#include <cstdio>
#include <cstdint>
namespace cg = cooperative_groups;

#ifndef SELF_POISON
#define SELF_POISON 0
#endif
#ifndef INPROJ_ALIGN
#define INPROJ_ALIGN true
#endif
#ifndef PROBE_REP
#define PROBE_REP 0
#endif
#ifndef DBG_W
#define DBG_W 0
#define DBG_IN 0
#define DBG_GLA 1
#define DBG_DIFF 0
#define DBG_DIL 1
#define DBG_MERGE 1
#define DBG_OUT 1
#endif
#ifndef DBG_ENC
#define DBG_ENC 0
#endif
#ifndef DBG_SP2
#define DBG_SP2 true
#endif
#ifndef DEBUG_CHECK
#define DEBUG_CHECK 0
#endif

namespace pg8 {
#define PG8_LAS __attribute__((address_space(3)))
typedef unsigned short bf16_t;
typedef short bf16x8 __attribute__((ext_vector_type(8)));
typedef float f32x4 __attribute__((ext_vector_type(4)));
typedef unsigned u32x4 __attribute__((ext_vector_type(4)));
constexpr int BM = 256, BK = 64, HALF = 128, HTB = HALF * BK * 2  , STAGE_BYTES = 8 * HTB, NXCD = 8, WGM = 4;

__host__ __device__ __forceinline__ int lds_byte(int r, int c) { const int st = (r >> 4) * 2 + (c >> 5), rr = r & 15, cc = c & 31, ob = rr * 64 + cc * 2; return st * 1024 + (ob ^ (((ob >> 9) & 1) << 5)); }
__host__ __device__ __forceinline__ void stage_rc(int b, int& R, int& C) { const int st = b / 1024, sb = b % 1024, swz = sb ^ (((sb >> 9) & 1) << 5); R = (st >> 1) * 16 + swz / 64; C = (st & 1) * 32 + (swz % 64) / 2; }
__host__ __device__ __forceinline__ int perm32(int rho) { const int n = rho >> 4, i = rho & 15; return 8 * (i >> 2) + 4 * n + (i & 3); }

struct Unit { int pm, pn; };
struct Gemm { const bf16_t* A; const bf16_t* Bt; int M, N, K; };

struct StaticOrder {
    int nM, nN, nwg, G, c;
    __host__ __device__ void init(int M, int N, int G_, int c_) { nM = M / BM; nN = N / BM; nwg = nM * nN; G = G_; c = c_; }
    __host__ __device__ bool next(int i, Unit& u) const {
        const long L = (long)i * G + c; if (L >= nwg) return false;
        int wgid = (int)L; { const int q = nwg / NXCD, r = nwg % NXCD, xcd = wgid % NXCD, off = wgid / NXCD; wgid = (xcd < r ? xcd * (q + 1) : r * (q + 1) + (xcd - r) * q) + off; }
        const int nig = WGM * nN, gid = wgid / nig, fm = gid * WGM, gsz = (nM - fm) < WGM ? (nM - fm) : WGM;
        u.pm = fm + ((wgid % nig) % gsz); u.pn = (wgid % nig) / gsz; return true;
    }
    __device__ __forceinline__ void a_ready(const Unit&) const {}
    __device__ __forceinline__ void done(const Unit&) const {}
};
template <class Epi, class Sched, bool ALIGN_EPI = false, bool SP2 = false>
__device__ __forceinline__ void gemm_phase(PG8_LAS unsigned char* lds, const Gemm g, const Sched& S, const Epi& E) {
    int tid_l = threadIdx.x; asm volatile("" : "+v"(tid_l));
    const int tid = tid_l, wid = __builtin_amdgcn_readfirstlane(tid >> 6), lane = tid & 63, wr = wid >> 2, wc = wid & 3, fr = lane & 15, fq = lane >> 4;
    const int K = g.K, nt = K / BK;
    unsigned voffA[2], voffB[2];
#pragma unroll
    for (int i = 0; i < 2; ++i) { int R, C; stage_rc(tid * 16 + i * 8192, R, C); const int Rb = Epi::PERM ? ((R & ~31) + perm32(R & 31)) : R;
        voffA[i] = (unsigned)(R * K + C) * 2u; voffB[i] = (unsigned)(Rb * K + C) * 2u; }
    const size_t kstep = (size_t)(BK * 2);
    const size_t hstep = (size_t)HALF * K * 2;
    const size_t tstep = 2 * hstep;
    const unsigned ldsw = (unsigned)wid * 1024u;
    const int aoff = lds_byte(wr * 64 + fr, fq * 8), boff = lds_byte(wc * 32 + fr, fq * 8);
#define PG8_SA(b, h) (((b) * 2 + (h)) * HTB)
#define PG8_SB(b, h) ((4 + (b) * 2 + (h)) * HTB)
#define PG8_STAGE(bufoff, gbase, voff) do { _Pragma("unroll") for (int _i = 0; _i < 2; ++_i) \
        __builtin_amdgcn_global_load_lds((const unsigned*)((const char*)(gbase) + (voff)[_i]), (PG8_LAS unsigned*)(lds + (bufoff) + ldsw + _i * 8192), 16, 0, 0); } while (0)
#define PG8_LDA(dst, b, h) do { _Pragma("unroll") for (int m = 0; m < 4; ++m) _Pragma("unroll") for (int k = 0; k < 2; ++k) dst[m][k] = *(const PG8_LAS bf16x8*)(lds + PG8_SA(b, h) + aoff + m * 2048 + k * 1024); } while (0)
#define PG8_LDB(dst, b, h) do { _Pragma("unroll") for (int n = 0; n < 2; ++n) _Pragma("unroll") for (int k = 0; k < 2; ++k) dst[n][k] = *(const PG8_LAS bf16x8*)(lds + PG8_SB(b, h) + boff + n * 2048 + k * 1024); } while (0)
#define PG8_MMA(ai, bj, At, Bt) do { __builtin_amdgcn_s_setprio(1); _Pragma("unroll") for (int m = 0; m < 4; ++m) _Pragma("unroll") for (int n = 0; n < 2; ++n) _Pragma("unroll") for (int k = 0; k < 2; ++k) \
        acc[ai][bj][m][n] = __builtin_amdgcn_mfma_f32_16x16x32_bf16(Bt[n][k], At[m][k], acc[ai][bj][m][n], 0, 0, 0); __builtin_amdgcn_s_setprio(0); } while (0)
#define PG8_WAIT_V(n) asm volatile("s_waitcnt vmcnt(" #n ")" ::: "memory")
#define PG8_WAIT_L(n) asm volatile("s_waitcnt lgkmcnt(" #n ")" ::: "memory")
#define PG8_BAR __builtin_amdgcn_s_barrier()
#define PG8_SCHED __builtin_amdgcn_sched_barrier(0)
    Unit cur, nxt; int ui = 0;
    if (!S.next(0, cur)) return;
    f32x4 acc[2][2][4][2];
#pragma unroll
    for (int a = 0; a < 2; ++a)
#pragma unroll
        for (int b = 0; b < 2; ++b)
#pragma unroll
            for (int m = 0; m < 4; ++m)
#pragma unroll
                for (int n = 0; n < 2; ++n) acc[a][b][m][n] = (f32x4){0.f, 0.f, 0.f, 0.f};
    bf16x8 At[4][2], B0[2][2], B1[2][2];
    const char* cA = (const char*)g.A + (size_t)cur.pm * tstep; const char* cB = (const char*)g.Bt + (size_t)cur.pn * tstep;
    S.a_ready(cur);
    if constexpr (SP2) {
        PG8_STAGE(PG8_SB(0, 0), cB, voffB); PG8_STAGE(PG8_SB(0, 1), cB + hstep, voffB); PG8_STAGE(PG8_SA(0, 0), cA, voffA); PG8_STAGE(PG8_SA(0, 1), cA + hstep, voffA);
        if (wr == 1) PG8_BAR;
        PG8_WAIT_V(2); PG8_BAR;
        PG8_STAGE(PG8_SB(1, 0), cB + kstep, voffB); PG8_STAGE(PG8_SA(1, 0), cA + kstep, voffA); PG8_STAGE(PG8_SB(1, 1), cB + hstep + kstep, voffB);
        PG8_WAIT_V(6); PG8_BAR;
    } else {
        PG8_STAGE(PG8_SB(0, 0), cB, voffB); PG8_STAGE(PG8_SA(0, 0), cA, voffA); PG8_STAGE(PG8_SB(0, 1), cB + hstep, voffB); PG8_STAGE(PG8_SA(0, 1), cA + hstep, voffA);
        if (wr == 1) PG8_BAR;
        PG8_WAIT_V(4); PG8_BAR;
        PG8_STAGE(PG8_SB(1, 0), cB + kstep, voffB); PG8_STAGE(PG8_SA(1, 0), cA + kstep, voffA); PG8_STAGE(PG8_SB(1, 1), cB + hstep + kstep, voffB);
        PG8_WAIT_V(6); PG8_BAR;
    }
    for (;;) {
        const bool has_next = S.next(ui + 1, nxt);
        const char* nA = has_next ? (const char*)g.A + (size_t)nxt.pm * tstep : cA; const char* nB = has_next ? (const char*)g.Bt + (size_t)nxt.pn * tstep : cB;
        for (int t = 0; t < nt; t += 2) {
            const bool last = (t == nt - 2);
            const char* a1 = cA + (size_t)(t + 1) * kstep;
            const char* a2 = last ? nA : cA + (size_t)(t + 2) * kstep; const char* b2 = last ? nB : cB + (size_t)(t + 2) * kstep;
            const char* a3 = a2 + kstep; const char* b3 = b2 + kstep;
            if (last && has_next) S.a_ready(nxt);
            if constexpr (SP2) {
            PG8_LDB(B0, 0, 0); PG8_LDB(B1, 0, 1); PG8_SCHED; PG8_LDA(At, 0, 0); PG8_STAGE(PG8_SA(1, 1), a1 + hstep, voffA);
            PG8_WAIT_V(8); PG8_WAIT_L(0); PG8_BAR; PG8_MMA(0, 0, At, B0); PG8_MMA(0, 1, At, B1); PG8_BAR; PG8_SCHED;
            PG8_LDA(At, 0, 1); PG8_STAGE(PG8_SB(0, 0), b2, voffB); PG8_STAGE(PG8_SB(0, 1), b2 + hstep, voffB); PG8_STAGE(PG8_SA(0, 0), a2, voffA);
            PG8_WAIT_V(8); PG8_WAIT_L(0); PG8_BAR; PG8_MMA(1, 0, At, B0); PG8_MMA(1, 1, At, B1); PG8_BAR; PG8_SCHED;
            PG8_LDB(B0, 1, 0); PG8_LDB(B1, 1, 1); PG8_SCHED; PG8_LDA(At, 1, 0); PG8_STAGE(PG8_SA(0, 1), a2 + hstep, voffA);
            PG8_WAIT_V(8); PG8_WAIT_L(0); PG8_BAR; PG8_MMA(0, 0, At, B0); PG8_MMA(0, 1, At, B1); PG8_BAR; PG8_SCHED;
            PG8_LDA(At, 1, 1); PG8_STAGE(PG8_SB(1, 0), b3, voffB); PG8_STAGE(PG8_SB(1, 1), b3 + hstep, voffB); PG8_STAGE(PG8_SA(1, 0), a3, voffA);
            PG8_WAIT_V(8); PG8_WAIT_L(0); PG8_BAR; PG8_MMA(1, 0, At, B0); PG8_MMA(1, 1, At, B1); PG8_BAR; PG8_SCHED;
            } else {
            PG8_LDB(B0, 0, 0); PG8_SCHED; PG8_LDA(At, 0, 0); PG8_STAGE(PG8_SA(1, 1), a1 + hstep, voffA);
            PG8_WAIT_L(8); PG8_BAR; PG8_WAIT_L(0); PG8_MMA(0, 0, At, B0); PG8_BAR; PG8_SCHED;
            PG8_LDB(B1, 0, 1); PG8_STAGE(PG8_SB(0, 0), b2, voffB);
            PG8_BAR; PG8_WAIT_L(0); PG8_MMA(0, 1, At, B1); PG8_BAR;
            PG8_LDA(At, 0, 1); PG8_STAGE(PG8_SA(0, 0), a2, voffA);
            PG8_BAR; PG8_WAIT_L(0); PG8_MMA(1, 0, At, B0); PG8_BAR; PG8_SCHED;
            PG8_STAGE(PG8_SB(0, 1), b2 + hstep, voffB);
            PG8_WAIT_V(6); PG8_BAR; PG8_MMA(1, 1, At, B1); PG8_BAR;
            PG8_LDB(B0, 1, 0); PG8_SCHED; PG8_LDA(At, 1, 0); PG8_STAGE(PG8_SA(0, 1), a2 + hstep, voffA);
            PG8_WAIT_L(8); PG8_BAR; PG8_WAIT_L(0); PG8_MMA(0, 0, At, B0); PG8_BAR; PG8_SCHED;
            PG8_LDB(B1, 1, 1); PG8_STAGE(PG8_SB(1, 0), b3, voffB);
            PG8_BAR; PG8_WAIT_L(0); PG8_MMA(0, 1, At, B1); PG8_BAR;
            PG8_LDA(At, 1, 1); PG8_STAGE(PG8_SA(1, 0), a3, voffA);
            PG8_BAR; PG8_WAIT_L(0); PG8_MMA(1, 0, At, B0); PG8_BAR; PG8_SCHED;
            PG8_STAGE(PG8_SB(1, 1), b3 + hstep, voffB);
            PG8_WAIT_V(6); PG8_BAR; PG8_MMA(1, 1, At, B1); PG8_BAR;
            }
        }
        if constexpr (ALIGN_EPI) { if (wr == 0) PG8_BAR; }
        bool zero_acc = true;
        if constexpr (!Epi::AFTER_DRAIN) { zero_acc = E(acc, cur, wr, wc, fr, fq); S.done(cur); }
        if (!has_next) break;
        if (zero_acc) {
#pragma unroll
        for (int a = 0; a < 2; ++a)
#pragma unroll
            for (int b = 0; b < 2; ++b)
#pragma unroll
                for (int m = 0; m < 4; ++m)
#pragma unroll
                    for (int n = 0; n < 2; ++n) acc[a][b][m][n] = (f32x4){0.f, 0.f, 0.f, 0.f};
        }
        cur = nxt; cA = nA; cB = nB; ++ui;
        if constexpr (ALIGN_EPI) { if (wr == 1) PG8_BAR; }
    }
    PG8_WAIT_V(0);
    if constexpr (!ALIGN_EPI) { if (wr == 0) PG8_BAR; }
    PG8_BAR;
    if constexpr (Epi::AFTER_DRAIN) { E.fused(acc, cur, wr, wc, fr, fq, lds, wid, lane); S.done(cur); }
#undef PG8_SA
#undef PG8_SB
#undef PG8_STAGE
#undef PG8_LDA
#undef PG8_LDB
#undef PG8_MMA
#undef PG8_WAIT_V
#undef PG8_WAIT_L
#undef PG8_BAR
#undef PG8_SCHED
}
}

typedef unsigned short bf16_t;
typedef short bf16x8 __attribute__((ext_vector_type(8)));
typedef float f32x16 __attribute__((ext_vector_type(16)));
typedef float f32x4 __attribute__((ext_vector_type(4)));
typedef float f32x2 __attribute__((ext_vector_type(2)));
typedef __bf16 bf16x2_t __attribute__((ext_vector_type(2)));
typedef unsigned u32x4 __attribute__((ext_vector_type(4)));
typedef unsigned u32x2 __attribute__((ext_vector_type(2)));

#define DI __device__ __forceinline__
#define MFMA32(a, b, c) __builtin_amdgcn_mfma_f32_32x32x16_bf16((a), (b), (c), 0, 0, 0)

constexpr int T_ = 16384, S_ = 2048, DM = 1024, NP = 8960, DEPTH = 4, NT = 512;
constexpr int AQ = 0, AK = 256, AV = 512, AG = 1024, BQ = 1536, BKc = 2048, BV = 2560, BG = 3072, CQ = 3584, CK = 4096, CV = 4608, CG = 5120, MG = 5632, LF = 8704;
constexpr int LDS_BYTES = 147456, ITEM_OFF = LDS_BYTES - 16, GLA_HALF = 63488;
constexpr float EPS = 1e-6f, LOG2E = 1.4426950408889634f;

constexpr size_t OFF_WI = 0, OFF_WB = OFF_WI + (size_t)4 * NP * 1024 * 2, OFF_WO = OFF_WB + (size_t)12 * 1024 * 512 * 2, OFF_P = OFF_WO + (size_t)4 * 1024 * 1024 * 2,
                 OFF_XB = OFF_P + (size_t)T_ * NP * 2, OFF_Y = OFF_XB + (size_t)T_ * DM * 2, OFF_MIX = OFF_Y + (size_t)3 * T_ * 512 * 2, OFF_UT = OFF_MIX + (size_t)T_ * DM * 2,
                 OFF_QH = OFF_UT + (size_t)2 * 1024 * 8192 * 2, OFF_DEC = OFF_QH + (size_t)2 * 1024 * 4096 * 2, OFF_SS = OFF_DEC + (size_t)2 * 1024 * 64 * 4,
                 OFF_SCAL = OFF_SS + (size_t)5 * T_ * 16 * 4, OFF_CNT = OFF_SCAL + 256, OFF_LSE = OFF_CNT + 256, OFF_BAR = OFF_LSE + (size_t)2 * T_ * 8 * 4, WS_END = OFF_BAR + 16384;
struct Params {
  const float *x, *norm_g, *w_in, *gate_up, *gate_b, *gla_norm_g, *diff_lambda, *diff_norm_g, *w_branch, *w_out, *final_g;
  float* out; char* ws;
  __device__ __forceinline__ bf16_t* Wi_() const { return (bf16_t*)(ws + OFF_WI); }
  __device__ __forceinline__ bf16_t* Wb_() const { return (bf16_t*)(ws + OFF_WB); }
  __device__ __forceinline__ bf16_t* Wo_() const { return (bf16_t*)(ws + OFF_WO); }
  __device__ __forceinline__ bf16_t* P_() const { return (bf16_t*)(ws + OFF_P); }
  __device__ __forceinline__ bf16_t* XB_() const { return (bf16_t*)(ws + OFF_XB); }
  __device__ __forceinline__ bf16_t* Y_() const { return (bf16_t*)(ws + OFF_Y); }
  __device__ __forceinline__ bf16_t* MIX_() const { return (bf16_t*)(ws + OFF_MIX); }
  __device__ __forceinline__ float* OA_() const { return (float*)(ws + OFF_MIX); }
  __device__ __forceinline__ bf16_t* UT_() const { return (bf16_t*)(ws + OFF_UT); }
  __device__ __forceinline__ bf16_t* QH_() const { return (bf16_t*)(ws + OFF_QH); }
  __device__ __forceinline__ float* DEC_() const { return (float*)(ws + OFF_DEC); }
  __device__ __forceinline__ float* SS_() const { return (float*)(ws + OFF_SS); }
  __device__ __forceinline__ float* scal_() const { return (float*)(ws + OFF_SCAL); }
  __device__ __forceinline__ int* cnt_() const { return (int*)(ws + OFF_CNT); }
  __device__ __forceinline__ float* LSE_() const { return (float*)(ws + OFF_LSE); }
};

DI unsigned pk2(float lo, float hi) { f32x2 v = {lo, hi}; bf16x2_t b = __builtin_convertvector(v, bf16x2_t); return __builtin_bit_cast(unsigned, b); }
DI float bflo(unsigned u) { return __uint_as_float(u << 16); }
DI float bfhi(unsigned u) { return __uint_as_float(u & 0xffff0000u); }
DI float bf2f(bf16_t h) { return __uint_as_float(((unsigned)h) << 16); }
DI int crow(int reg, int hh) { return (reg & 3) + 8 * (reg >> 2) + 4 * hh; }
DI float ex2(float x) { return __builtin_amdgcn_exp2f(x); }
DI float siluf(float x) { return x * __builtin_amdgcn_rcpf(1.f + __expf(-x)); }
DI float sigmf(float x) { return __builtin_amdgcn_rcpf(1.f + __expf(-x)); }
DI float logsig(float z) { return fminf(z, 0.f) - __logf(1.f + __expf(-fabsf(z))); }
DI bf16x8 pack_step(const f32x16& x, int s) {
  u32x4 p;
  p[0] = pk2(x[8 * s + 0], x[8 * s + 1]); p[1] = pk2(x[8 * s + 2], x[8 * s + 3]);
  p[2] = pk2(x[8 * s + 4], x[8 * s + 5]); p[3] = pk2(x[8 * s + 6], x[8 * s + 7]);
  return __builtin_bit_cast(bf16x8, p);
}
DI bf16x8 cat2(u32x2 lo, u32x2 hi) { u32x4 v = {lo[0], lo[1], hi[0], hi[1]}; return __builtin_bit_cast(bf16x8, v); }
DI void tr4x8(const u32x4& r0, const u32x4& r1, const u32x4& r2, const u32x4& r3, u32x2 (&o)[8]) {
#pragma unroll
  for (int wd = 0; wd < 4; ++wd) {
    const unsigned a = r0[wd], b = r1[wd], c = r2[wd], d = r3[wd];
    o[2 * wd][0] = (a & 0xffffu) | (b << 16); o[2 * wd][1] = (c & 0xffffu) | (d << 16);
    o[2 * wd + 1][0] = (a >> 16) | (b & 0xffff0000u); o[2 * wd + 1][1] = (c >> 16) | (d & 0xffff0000u);
  }
}
#define LDS_BARRIER() do { asm volatile("s_waitcnt lgkmcnt(0)" ::: "memory"); __builtin_amdgcn_s_barrier(); asm volatile("" ::: "memory"); } while (0)
DI f32x16 zero16() { f32x16 z; for (int i = 0; i < 16; ++i) z[i] = 0.f; return z; }
DI float row_rs(const float* __restrict__ SSl, int t) {
  const f32x4 a = *(const f32x4*)(SSl + (size_t)t * 16), b = *(const f32x4*)(SSl + (size_t)t * 16 + 4);
  const f32x4 c = *(const f32x4*)(SSl + (size_t)t * 16 + 8), d = *(const f32x4*)(SSl + (size_t)t * 16 + 12);
  const float ss = (((a[0] + a[1]) + (a[2] + a[3])) + ((b[0] + b[1]) + (b[2] + b[3]))) + (((c[0] + c[1]) + (c[2] + c[3])) + ((d[0] + d[1]) + (d[2] + d[3])));
  return rsqrtf(ss * (1.f / 1024.f) + EPS);
}
DI int win_col(int n) {
  const bool rope = (n >= BQ && n < BV) || (n >= CQ && n < CV);
  if (rope) { const int p = n & 63; n = (n & ~63) + 32 * ((p >> 2) & 1) + 16 * (p >> 5) + 4 * ((p >> 3) & 3) + (p & 3); }
  if (n < 1536) return n;
  if (n < LF) return n + 32;
  if (n < LF + 32) return n - LF + 1536;
  return -1;
}
DI float win_scale(int n) {
  if (n < AK) return 0.125f;
  if ((n >= BQ && n < BKc) || (n >= CQ && n < CK)) return 0.125f * LOG2E;
  return 1.f;
}

extern __shared__ __attribute__((aligned(16))) char g_lds[];
struct EpiInproj {
  static constexpr bool PERM = true, AFTER_DRAIN = false;
  bf16_t* P;
  DI bool operator()(pg8::f32x4 (&acc)[2][2][4][2], const pg8::Unit& u, int wr, int wc, int fr, int fq) const {
    const int colt = u.pn * 256;
    const PG8_LAS unsigned char* l3 = (const PG8_LAS unsigned char*)g_lds;
    const PG8_LAS int* ulist = (const PG8_LAS int*)(l3 + 131072 + 14336);
    const int key = (u.pm << 8) | u.pn; int slot = 0;
#pragma unroll
    for (int i = 1; i < 14; ++i) slot = ulist[i] == key ? i : slot;
    const PG8_LAS float* rsrow = (const PG8_LAS float*)(l3 + 131072) + slot * 256;
    const bool rope = (colt >= BQ && colt < BV) || (colt >= CQ && colt < CV);
    const bool gate = colt >= MG && colt < LF;
#pragma unroll
    for (int ai = 0; ai < 2; ++ai)
#pragma unroll
      for (int m = 0; m < 4; ++m) {
        const int row = u.pm * 256 + ai * 128 + wr * 64 + m * 16 + fr;
        const float rs = rsrow[ai * 128 + wr * 64 + m * 16 + fr];
        bf16_t* rowp = P + (size_t)row * NP;
#pragma unroll
        for (int bj = 0; bj < 2; ++bj) {
          const f32x4 v0 = acc[ai][bj][m][0] * rs, v1 = acc[ai][bj][m][1] * rs;
          if (gate) {
            float q[8];
#pragma unroll
            for (int j = 0; j < 4; ++j) { q[j] = 1.f + __expf(fminf(-v0[j], 80.f)); q[4 + j] = 1.f + __expf(fminf(-v1[j], 80.f)); }
            u32x4 o = {pk2(q[0], q[1]), pk2(q[2], q[3]), pk2(q[4], q[5]), pk2(q[6], q[7])};
            *(u32x4*)(rowp + colt + bj * 128 + wc * 32 + 8 * fq) = o;
          } else if (!rope) {
            u32x4 o = {pk2(v0[0], v0[1]), pk2(v0[2], v0[3]), pk2(v1[0], v1[1]), pk2(v1[2], v1[3])};
            *(u32x4*)(rowp + colt + bj * 128 + wc * 32 + 8 * fq) = o;
          } else {
            const int d0 = 16 * (wc & 1) + 4 * fq;
            const float pos = (float)(row & (S_ - 1));
            float y1[4], y2[4];
#pragma unroll
            for (int j = 0; j < 4; ++j) {
              const float inv = ex2(-(float)(d0 + j) * 0.41524101186f);
              float rev = (pos * inv) * 0.15915494309189535f;
              rev -= floorf(rev);
              const float sn = __builtin_amdgcn_sinf(rev), cs = __builtin_amdgcn_cosf(rev);
              y1[j] = v0[j] * cs - v1[j] * sn; y2[j] = v1[j] * cs + v0[j] * sn;
            }
            bf16_t* hp = rowp + colt + bj * 128 + (wc >> 1) * 64 + d0;
            u32x2 o1 = {pk2(y1[0], y1[1]), pk2(y1[2], y1[3])}, o2 = {pk2(y2[0], y2[1]), pk2(y2[2], y2[3])};
            *(u32x2*)hp = o1; *(u32x2*)(hp + 32) = o2;
          }
        }
      }
    return true;
  }
};
struct EpiNullProbe {
  static constexpr bool PERM = true, AFTER_DRAIN = false;
  float* sink; const float* flag; const float* SSp;
  DI bool operator()(pg8::f32x4 (&acc)[2][2][4][2], const pg8::Unit& u, int wr, int wc, int fr, int fq) const {
    float rsum = 0.f;
#pragma unroll
    for (int ai = 0; ai < 2; ++ai)
#pragma unroll
      for (int m = 0; m < 4; ++m) rsum += row_rs(SSp, u.pm * 256 + ai * 128 + wr * 64 + m * 16 + fr);
    if (rsum == 12345.678f) {
      float s = 0.f;
#pragma unroll
      for (int ai = 0; ai < 2; ++ai)
#pragma unroll
        for (int bj = 0; bj < 2; ++bj)
#pragma unroll
          for (int m = 0; m < 4; ++m) s += acc[ai][bj][m][0][0] + acc[ai][bj][m][1][3] + acc[ai][bj][m][0][2] + acc[ai][bj][m][1][1];
      sink[u.pm * 64 + fr] = s;
    }
    return true;
  }
};
struct EpiMerge {
  static constexpr bool PERM = true, AFTER_DRAIN = false;
  const bf16_t* P; bf16_t* MIX;
  DI bool operator()(pg8::f32x4 (&acc)[2][2][4][2], const pg8::Unit& u, int wr, int wc, int fr, int fq) const {
    const int g = u.pn >> 2, colt = (u.pn & 3) * 256, rowt = (u.pm & 63) * 256;
#pragma unroll
    for (int ai = 0; ai < 2; ++ai)
#pragma unroll
      for (int m = 0; m < 4; ++m) {
        const int row = rowt + ai * 128 + wr * 64 + m * 16 + fr;
#pragma unroll
        for (int bj = 0; bj < 2; ++bj) {
          const int col0 = colt + bj * 128 + wc * 32 + 8 * fq;
          const u32x4 ga = *(const u32x4*)(P + (size_t)row * NP + MG + g * 1024 + col0);
          float f[8] = {__builtin_amdgcn_rcpf(bflo(ga[0])), __builtin_amdgcn_rcpf(bfhi(ga[0])), __builtin_amdgcn_rcpf(bflo(ga[1])), __builtin_amdgcn_rcpf(bfhi(ga[1])),
                        __builtin_amdgcn_rcpf(bflo(ga[2])), __builtin_amdgcn_rcpf(bfhi(ga[2])), __builtin_amdgcn_rcpf(bflo(ga[3])), __builtin_amdgcn_rcpf(bfhi(ga[3]))};
          if (g < 2) {
            const u32x4 gb = *(const u32x4*)(P + (size_t)row * NP + MG + (g + 1) * 1024 + col0);
            f[0] *= bflo(gb[0]); f[1] *= bfhi(gb[0]); f[2] *= bflo(gb[1]); f[3] *= bfhi(gb[1]); f[4] *= bflo(gb[2]); f[5] *= bfhi(gb[2]); f[6] *= bflo(gb[3]); f[7] *= bfhi(gb[3]);
          }
#pragma unroll
          for (int j = 0; j < 4; ++j) { acc[ai][bj][m][0][j] *= f[j]; acc[ai][bj][m][1][j] *= f[4 + j]; }
          if (g == 2) {
            const pg8::f32x4 v0 = acc[ai][bj][m][0], v1 = acc[ai][bj][m][1];
            u32x4 o = {pk2(v0[0], v0[1]), pk2(v0[2], v0[3]), pk2(v1[0], v1[1]), pk2(v1[2], v1[3])};
            *(u32x4*)(MIX + (size_t)row * DM + col0) = o;
          }
        }
      }
    return g == 2;
  }
};
struct MergeOrder {
  int G, c;
  DI bool next(int i, pg8::Unit& u) const {
    const int tile = c + (i / 3) * G, g = i % 3;
    if (tile >= 256) return false;
    u.pm = g * 64 + (tile >> 2); u.pn = g * 4 + (tile & 3); return true;
  }
  DI void a_ready(const pg8::Unit&) const {}
  DI void done(const pg8::Unit&) const {}
};
struct EpiOut {
  static constexpr bool PERM = true, AFTER_DRAIN = false;
  const float* X0; bf16_t* XB; float* SSn;
  DI bool operator()(pg8::f32x4 (&acc)[2][2][4][2], const pg8::Unit& u, int wr, int wc, int fr, int fq) const {
    const int colt = u.pn * 256;
#pragma unroll
    for (int ai = 0; ai < 2; ++ai)
#pragma unroll
      for (int m = 0; m < 4; ++m) {
        const int row = u.pm * 256 + ai * 128 + wr * 64 + m * 16 + fr;
        float ss = 0.f;
#pragma unroll
        for (int bj = 0; bj < 2; ++bj) {
          const size_t off = (size_t)row * DM + colt + bj * 128 + wc * 32 + 8 * fq;
          pg8::f32x4 x0, x1;
          if (X0) { x0 = *(const pg8::f32x4*)(X0 + off); x1 = *(const pg8::f32x4*)(X0 + off + 4); }
          else { const u32x4 xb = *(const u32x4*)(XB + off); x0 = (pg8::f32x4){bflo(xb[0]), bfhi(xb[0]), bflo(xb[1]), bfhi(xb[1])}; x1 = (pg8::f32x4){bflo(xb[2]), bfhi(xb[2]), bflo(xb[3]), bfhi(xb[3])}; }
          x0 += acc[ai][bj][m][0]; x1 += acc[ai][bj][m][1];
          u32x4 o = {pk2(x0[0], x0[1]), pk2(x0[2], x0[3]), pk2(x1[0], x1[1]), pk2(x1[2], x1[3])};
          *(u32x4*)(XB + off) = o;
          const float r0 = bflo(o[0]), r1 = bfhi(o[0]), r2 = bflo(o[1]), r3 = bfhi(o[1]), r4 = bflo(o[2]), r5 = bfhi(o[2]), r6 = bflo(o[3]), r7 = bfhi(o[3]);
          ss += ((r0 * r0 + r1 * r1) + (r2 * r2 + r3 * r3)) + ((r4 * r4 + r5 * r5) + (r6 * r6 + r7 * r7));
        }
        ss += __shfl_xor(ss, 16); ss += __shfl_xor(ss, 32);
        if (fq == 0) SSn[(size_t)row * 16 + u.pn * 4 + wc] = ss;
      }
    return true;
  }
};

DI void conv_tile(bool active, const float* __restrict__ src, int ld, int kind, const float* __restrict__ rs, bf16_t* __restrict__ dst, int K, int n0, int k0, char* ldsh, int tid) {
  float* tl = (float*)ldsh;
  if (active) {
    const int nn = tid & 63, n = n0 + nn;
    const int col = kind == 0 ? win_col(n) : n;
    const float cs = kind == 0 ? win_scale(n) : 1.f;
    float vv[16];
#pragma unroll
    for (int i = 0; i < 16; ++i) vv[i] = col >= 0 ? src[(size_t)(k0 + (tid >> 6) + 4 * i) * ld + col] : 0.f;
#pragma unroll
    for (int i = 0; i < 16; ++i) {
      const int kk = (tid >> 6) + 4 * i;
      float v = vv[i] * cs; if (rs) v *= rs[k0 + kk];
      tl[kk * 65 + nn] = v;
    }
  }
  __syncthreads();
  if (active) {
    const int nl = tid >> 2, kq = tid & 3;
    u32x4 o0, o1;
#pragma unroll
    for (int j = 0; j < 4; ++j) {
      o0[j] = pk2(tl[(kq * 16 + 2 * j) * 65 + nl], tl[(kq * 16 + 2 * j + 1) * 65 + nl]);
      o1[j] = pk2(tl[(kq * 16 + 8 + 2 * j) * 65 + nl], tl[(kq * 16 + 8 + 2 * j + 1) * 65 + nl]);
    }
    bf16_t* dp = dst + (size_t)(n0 + nl) * K + k0 + kq * 16;
    *(u32x4*)dp = o0; *(u32x4*)(dp + 8) = o1;
  }
  __syncthreads();
}

DI void prologue(const Params& p, char* lds) {
  int tidf = threadIdx.x; asm volatile("" : "+v"(tidf)); const int lane = tidf & 63, half = tidf >> 8, tid = tidf & 255;
  constexpr int NTN = NP / 64, NT_WI = 4 * NTN * 16, NT_WB = 12 * 16 * 8, NT_WO = 4 * 16 * 16, NT_ALL = NT_WI + NT_WB + NT_WO;
  for (int base = blockIdx.x * 2; base < NT_ALL; base += gridDim.x * 2) {
    const int tile = base + half; const bool act = tile < NT_ALL;
    char* ldsh = lds + half * 16896;
    if (tile < NT_WI) {
      const int l = tile / (NTN * 16), rem = tile % (NTN * 16), nt = rem >> 4, kt = rem & 15;
      conv_tile(act, p.w_in + (size_t)l * 1024 * 8736, 8736, 0, p.norm_g + l * 1024, p.Wi_() + (size_t)l * NP * 1024, 1024, nt * 64, kt * 64, ldsh, tid);
    } else if (tile < NT_WI + NT_WB) {
      const int t2 = tile - NT_WI, mtx = t2 >> 7, rem = t2 & 127, nt = rem >> 3, kt = rem & 7;
      conv_tile(act, p.w_branch + (size_t)mtx * 512 * 1024, 1024, 1, nullptr, p.Wb_() + (size_t)mtx * 1024 * 512, 512, nt * 64, kt * 64, ldsh, tid);
    } else {
      const int t2 = (act ? tile : NT_ALL - 1) - NT_WI - NT_WB, l = t2 >> 8, rem = t2 & 255, nt = rem >> 4, kt = rem & 15;
      conv_tile(act, p.w_out + (size_t)l * 1024 * 1024, 1024, 1, nullptr, p.Wo_() + (size_t)l * 1024 * 1024, 1024, nt * 64, kt * 64, ldsh, tid);
    }
  }
  const int gw = (blockIdx.x * NT + tidf) >> 6, nw = gridDim.x * (NT / 64);
  for (int t = gw; t < T_; t += nw) {
    float ss = 0.f;
#pragma unroll
    for (int i = 0; i < 4; ++i) {
      const f32x4 v = *(const f32x4*)(p.x + (size_t)t * DM + i * 256 + lane * 4);
      ss += v[0] * v[0] + v[1] * v[1] + v[2] * v[2] + v[3] * v[3];
      u32x2 o = {pk2(v[0], v[1]), pk2(v[2], v[3])};
      *(u32x2*)(p.XB_() + (size_t)t * DM + i * 256 + lane * 4) = o;
    }
#pragma unroll
    for (int s = 32; s > 0; s >>= 1) ss += __shfl_xor(ss, s);
    if (lane < 16) p.SS_()[(size_t)t * 16 + lane] = lane == 0 ? ss : 0.f;
  }
#if SELF_POISON
  {
    const size_t gt0 = (size_t)blockIdx.x * NT + tidf, gs0 = (size_t)gridDim.x * NT;
    u32x4 nanv = {0xffffffffu, 0xffffffffu, 0xffffffffu, 0xffffffffu};
    for (size_t i = gt0; i < (size_t)T_ * NP / 8; i += gs0) ((u32x4*)p.P_())[i] = nanv;
    for (size_t i = gt0; i < (size_t)T_ * 1536 / 8; i += gs0) ((u32x4*)p.Y_())[i] = nanv;
    for (size_t i = gt0; i < (size_t)T_ * DM / 8; i += gs0) ((u32x4*)p.MIX_())[i] = nanv;
    for (size_t i = gt0; i < (size_t)T_ * DM / 4; i += gs0) ((u32x4*)p.out)[i] = nanv;
  }
#endif
  const int gt = blockIdx.x * NT + tidf;
  if (gt < 64) p.cnt_()[gt] = 0;
  if (gt < DEPTH) {
    const int l = gt; const float* dl = p.diff_lambda + l * 256;
    float s1 = 0.f, s2 = 0.f;
    for (int i = 0; i < 64; ++i) { s1 += dl[i] * dl[64 + i]; s2 += dl[128 + i] * dl[192 + i]; }
    const float li = 0.8f - 0.6f * expf(-0.3f * (float)l);
    p.scal_()[l] = expf(s1) - expf(s2) + li; p.scal_()[4 + l] = li;
  }
}

#define DIFF_STEP(KR, VR, JT, CUR) do { \
    bf16_t* KsW = Ks + (1 - (CUR)) * 17408; bf16_t* VtW = KsW + 64 * 136; \
    const bf16_t* KsC = Ks + (CUR) * 17408; const bf16_t* VtC = KsC + 64 * 136; \
    if ((JT) + 1 < 32) { \
      _Pragma("unroll") \
      for (int i = 0; i < 2; ++i) *(u32x4*)(KsW + (krow_ + 32 * i) * 136 + kc) = KR[i]; \
      _Pragma("unroll") \
      for (int wd = 0; wd < 4; ++wd) { \
        const unsigned a = VR[0][wd], c = VR[1][wd]; \
        *(unsigned*)(VtW + (ec * 8 + 2 * wd) * 68 + 2 * kg2) = (a & 0xffffu) | (c << 16); \
        *(unsigned*)(VtW + (ec * 8 + 2 * wd + 1) * 68 + 2 * kg2) = (a >> 16) | (c & 0xffff0000u); \
      } \
    } \
    if ((JT) + 3 < 32) { \
      const bf16_t* base = Pb + (size_t)(((JT) + 3) * 64) * NP; \
      _Pragma("unroll") \
      for (int i = 0; i < 2; ++i) { \
        KR[i] = *(const u32x4*)(base + (size_t)(krow_ + 32 * i) * NP + BKc + h * 128 + kc); \
        VR[i] = *(const u32x4*)(base + (size_t)(2 * kg2 + i) * NP + BV + h * 128 + ec * 8); \
      } \
    } \
    f32x16 s0, s1; \
    __builtin_amdgcn_s_setprio(1); \
    _Pragma("unroll") \
    for (int ks = 0; ks < 4; ++ks) { \
      const bf16x8 k0 = *(const bf16x8*)(KsC + r * 136 + comp * 64 + ks * 16 + hh * 8); \
      const bf16x8 k1 = *(const bf16x8*)(KsC + (32 + r) * 136 + comp * 64 + ks * 16 + hh * 8); \
      if (ks == 0) { s0 = MFMA32(k0, qf[0], negm); s1 = MFMA32(k1, qf[0], negm); } \
      else { s0 = MFMA32(k0, qf[ks], s0); s1 = MFMA32(k1, qf[ks], s1); } \
    } \
    __builtin_amdgcn_s_setprio(0); \
    float mx = s0[0]; \
    _Pragma("unroll") \
    for (int i = 0; i < 16; ++i) { mx = fmaxf(mx, s0[i]); mx = fmaxf(mx, s1[i]); } \
    mx = fmaxf(mx, __shfl_xor(mx, 32)); \
    if (__any(mx > 8.f)) { \
      const float dl = fmaxf(mx, 0.f), alpha = ex2(-dl); \
      m += dl; lsum *= alpha; \
      _Pragma("unroll") \
      for (int i = 0; i < 16; ++i) { s0[i] -= dl; s1[i] -= dl; negm[i] = -m; } \
      _Pragma("unroll") \
      for (int et = 0; et < 4; ++et) \
        _Pragma("unroll") \
        for (int i = 0; i < 16; ++i) o[et][i] *= alpha; \
    } \
    float ps = 0.f; \
    _Pragma("unroll") \
    for (int i = 0; i < 16; ++i) { s0[i] = ex2(s0[i]); s1[i] = ex2(s1[i]); ps += s0[i] + s1[i]; } \
    lsum += ps; \
    __builtin_amdgcn_s_setprio(1); \
    _Pragma("unroll") \
    for (int u = 0; u < 2; ++u) \
      _Pragma("unroll") \
      for (int s = 0; s < 2; ++s) { \
        const bf16x8 pb = u == 0 ? pack_step(s0, s) : pack_step(s1, s); \
        _Pragma("unroll") \
        for (int et = 0; et < 4; ++et) { \
          const bf16_t* vp = VtC + (et * 32 + r) * 68 + u * 32 + s * 16 + hh * 4; \
          const bf16x8 va = cat2(*(const u32x2*)vp, *(const u32x2*)(vp + 8)); \
          o[et] = MFMA32(va, pb, o[et]); \
        } \
      } \
    __builtin_amdgcn_s_setprio(0); \
    LDS_BARRIER(); \
  } while (0)
DI void diff_item(const Params& p, int l, int b, int h, int qblk, char* lds) {
  int tid = threadIdx.x; asm volatile("" : "+v"(tid)); const int lane = tid & 63, w = tid >> 6, qg = w >> 1, comp = w & 1, r = lane & 31, hh = lane >> 5;
  bf16_t* Ks = (bf16_t*)lds; bf16_t* Vt = Ks + 64 * 136;
  const bf16_t* Pb = p.P_() + (size_t)(b * S_) * NP;
  bf16x8 qf[4];
  {
    const bf16_t* qp = Pb + (size_t)(qblk * 128 + qg * 32 + r) * NP + BQ + h * 128 + comp * 64 + hh * 8;
#pragma unroll
    for (int ks = 0; ks < 4; ++ks) qf[ks] = *(const bf16x8*)(qp + ks * 16);
  }
  f32x16 o[4]; o[0] = zero16(); o[1] = zero16(); o[2] = zero16(); o[3] = zero16();
  float m = 0.f, lsum = 0.f;
  f32x16 negm = zero16();
  u32x4 krA[2], vrA[2], krB[2], vrB[2];
  const int krow_ = tid >> 4, kc = (tid & 15) * 8, kg2 = tid & 31, ec = tid >> 5;
#pragma unroll
  for (int i = 0; i < 2; ++i) {
    krA[i] = *(const u32x4*)(Pb + (size_t)(krow_ + 32 * i) * NP + BKc + h * 128 + kc);
    vrA[i] = *(const u32x4*)(Pb + (size_t)(2 * kg2 + i) * NP + BV + h * 128 + ec * 8);
    krB[i] = *(const u32x4*)(Pb + (size_t)(64 + krow_ + 32 * i) * NP + BKc + h * 128 + kc);
    vrB[i] = *(const u32x4*)(Pb + (size_t)(64 + 2 * kg2 + i) * NP + BV + h * 128 + ec * 8);
  }
#pragma unroll
  for (int i = 0; i < 2; ++i) *(u32x4*)(Ks + (krow_ + 32 * i) * 136 + kc) = krA[i];
#pragma unroll
  for (int wd = 0; wd < 4; ++wd) {
    const unsigned a = vrA[0][wd], c = vrA[1][wd];
    *(unsigned*)(Vt + (ec * 8 + 2 * wd) * 68 + 2 * kg2) = (a & 0xffffu) | (c << 16);
    *(unsigned*)(Vt + (ec * 8 + 2 * wd + 1) * 68 + 2 * kg2) = (a >> 16) | (c & 0xffff0000u);
  }
#pragma unroll
  for (int i = 0; i < 2; ++i) {
    krA[i] = *(const u32x4*)(Pb + (size_t)(128 + krow_ + 32 * i) * NP + BKc + h * 128 + kc);
    vrA[i] = *(const u32x4*)(Pb + (size_t)(128 + 2 * kg2 + i) * NP + BV + h * 128 + ec * 8);
  }
  LDS_BARRIER();
#pragma unroll 1
  for (int jt = 0; jt < 32; jt += 2) {
    DIFF_STEP(krB, vrB, jt, 0);
    DIFF_STEP(krA, vrA, jt + 1, 1);
  }
  __syncthreads();
  const float lt = lsum + __shfl_xor(lsum, 32), inv = 1.f / lt;
  const float lam = p.scal_()[l], li = p.scal_()[4 + l];
  __syncthreads();
  float* cmb = (float*)lds;
  if (comp == 1) {
    const float f = lam * inv;
#pragma unroll
    for (int et = 0; et < 4; ++et)
#pragma unroll
      for (int i = 0; i < 16; ++i) cmb[(qg * 128 + et * 32 + crow(i, hh)) * 32 + r] = o[et][i] * f;
  }
  __syncthreads();
  if (comp == 0) {
    float ss = 0.f;
#pragma unroll
    for (int et = 0; et < 4; ++et)
#pragma unroll
      for (int i = 0; i < 16; ++i) { const float v = o[et][i] * inv - cmb[(qg * 128 + et * 32 + crow(i, hh)) * 32 + r]; o[et][i] = v; ss += v * v; }
    ss += __shfl_xor(ss, 32);
    const float sc = rsqrtf(ss * (1.f / 128.f) + EPS) * (1.f - li);
    const size_t t = (size_t)b * S_ + qblk * 128 + qg * 32 + r;
#pragma unroll
    for (int et = 0; et < 4; ++et)
#pragma unroll
      for (int g4 = 0; g4 < 4; ++g4) {
        const int e = et * 32 + 8 * g4 + 4 * hh;
        const u32x2 gv = *(const u32x2*)(p.P_() + t * NP + BG + h * 128 + e);
        const f32x4 gn = *(const f32x4*)(p.diff_norm_g + l * 128 + e);
        const float y0 = o[et][4 * g4] * sc * gn[0] * siluf(bflo(gv[0])), y1 = o[et][4 * g4 + 1] * sc * gn[1] * siluf(bfhi(gv[0]));
        const float y2 = o[et][4 * g4 + 2] * sc * gn[2] * siluf(bflo(gv[1])), y3 = o[et][4 * g4 + 3] * sc * gn[3] * siluf(bfhi(gv[1]));
        u32x2 ov = {pk2(y0, y1), pk2(y2, y3)};
        *(u32x2*)(p.Y_() + ((size_t)T_ + t) * 512 + h * 128 + e) = ov;
      }
  }
}

template <int G>
DI void dil_item(const Params& p, int item, char* lds) {
  int tid = threadIdx.x; asm volatile("" : "+v"(tid)); const int lane = tid & 63, w = tid >> 6, a = lane & 31, hh = lane >> 5;
  constexpr int sh = 2 * G, D = 1 << sh, Sr = S_ >> sh, NROWS = G < 2 ? 384 : 256, VP = 388;
  const int b = item >> 6, h = (item >> 3) & 7, sub = item & 7;
  bf16_t* Ks = (bf16_t*)lds;
  bf16_t* Vt = Ks + 384 * 72;
  const bf16_t* Pb = p.P_() + (size_t)(b * S_) * NP;
  const int cls0 = G < 2 ? (sub & (D - 1)) : sub * 2;
  const int big = G < 2 ? (sub >> sh) : 0;
  const int R0 = G < 2 ? big * 256 - 64 : 0;
  const int c_w = G < 2 ? cls0 : cls0 + (w >> 2);
  const int blk = G < 2 ? big * 8 + w : (w & 3);
  const int iq = blk * 32 + a, tokl = (iq << sh) + c_w;
  bf16x8 qf[4];
  {
    const bf16_t* qp = Pb + (size_t)tokl * NP + CQ + h * 64 + hh * 8;
#pragma unroll
    for (int ks = 0; ks < 4; ++ks) qf[ks] = *(const bf16x8*)(qp + ks * 16);
  }
  {
    constexpr int NKP = NROWS * 8 / 512, NVU = (NROWS / 4 * 8 + 511) / 512;
    u32x4 kr[NKP]; u32x4 vr[NVU][4];
#pragma unroll
    for (int i = 0; i < NKP; ++i) {
      const int piece = tid + 512 * i, rl = piece >> 3, c8 = piece & 7;
      int idx = G < 2 ? R0 + rl : (rl & 127); idx = idx < 0 ? 0 : (idx >= Sr ? Sr - 1 : idx);
      const int cls = G < 2 ? cls0 : cls0 + (rl >> 7);
      kr[i] = *(const u32x4*)(Pb + (size_t)((idx << sh) + cls) * NP + CK + h * 64 + c8 * 8);
    }
#pragma unroll
    for (int j = 0; j < NVU; ++j) {
      const int wu = tid + 512 * j, rg = wu >> 3, ec = wu & 7;
      if (wu < NROWS / 4 * 8) {
#pragma unroll
        for (int i = 0; i < 4; ++i) {
          const int rl = 4 * rg + i;
          int idx = G < 2 ? R0 + rl : (rl & 127); idx = idx < 0 ? 0 : (idx >= Sr ? Sr - 1 : idx);
          const int cls = G < 2 ? cls0 : cls0 + (rl >> 7);
          vr[j][i] = *(const u32x4*)(Pb + (size_t)((idx << sh) + cls) * NP + CV + h * 64 + ec * 8);
        }
      }
    }
#pragma unroll
    for (int i = 0; i < NKP; ++i) { const int piece = tid + 512 * i; *(u32x4*)(Ks + (piece >> 3) * 72 + (piece & 7) * 8) = kr[i]; }
#pragma unroll
    for (int j = 0; j < NVU; ++j) {
      const int wu = tid + 512 * j, rg = wu >> 3, ec = wu & 7;
      if (wu < NROWS / 4 * 8) {
        u32x2 tv[8]; tr4x8(vr[j][0], vr[j][1], vr[j][2], vr[j][3], tv);
#pragma unroll
        for (int x = 0; x < 8; ++x) *(u32x2*)(Vt + (ec * 8 + x) * VP + 4 * rg) = tv[x];
      }
    }
  }
  __syncthreads();
  f32x16 o[2]; o[0] = zero16(); o[1] = zero16();
  float m = -30000.f, lsum = 0.f;
#pragma unroll 1
  for (int j = 0; j < 5; ++j) {
    const int i0 = blk * 32 - 64 + 32 * j;
    if (i0 < 0 || i0 >= Sr) continue;
    const int rl0 = G < 2 ? w * 32 + 32 * j : (w >> 2) * 128 + i0;
    f32x16 st = zero16();
#pragma unroll
    for (int ks = 0; ks < 4; ++ks) { const bf16x8 kf = *(const bf16x8*)(Ks + (rl0 + a) * 72 + ks * 16 + hh * 8); st = MFMA32(kf, qf[ks], st); }
    float mx = -1e30f;
#pragma unroll
    for (int i = 0; i < 16; ++i) {
      const int dlt = i0 + crow(i, hh) - iq;
      const bool ok = (dlt <= 64) && (dlt >= -64);
      st[i] = ok ? st[i] : -1e30f;
      mx = fmaxf(mx, st[i]);
    }
    mx = fmaxf(mx, __shfl_xor(mx, 32));
    const float mn = fmaxf(m, mx), alpha = ex2(m - mn);
    m = mn;
    float ps = 0.f;
#pragma unroll
    for (int i = 0; i < 16; ++i) { st[i] = ex2(st[i] - mn); ps += st[i]; }
    lsum = lsum * alpha + ps;
#pragma unroll
    for (int i = 0; i < 16; ++i) { o[0][i] *= alpha; o[1][i] *= alpha; }
#pragma unroll
    for (int s = 0; s < 2; ++s) {
      const bf16x8 pb = pack_step(st, s);
#pragma unroll
      for (int et = 0; et < 2; ++et) {
        const bf16_t* vp = Vt + (et * 32 + a) * VP + rl0 + s * 16 + hh * 4;
        const bf16x8 va = cat2(*(const u32x2*)vp, *(const u32x2*)(vp + 8));
        o[et] = MFMA32(va, pb, o[et]);
      }
    }
  }
  const float lt = lsum + __shfl_xor(lsum, 32), inv = 1.f / lt;
  const float lse = m + __log2f(lt);
  const size_t t = (size_t)b * S_ + tokl;
  if (G < 2) {
    bf16_t* pp = (bf16_t*)p.out + ((size_t)G * T_ + t) * 512 + h * 64;
    if (hh == 0) p.LSE_()[((size_t)G * T_ + t) * 8 + h] = lse;
#pragma unroll
    for (int et = 0; et < 2; ++et)
#pragma unroll
      for (int g4 = 0; g4 < 4; ++g4) {
        u32x2 ov = {pk2(o[et][4 * g4] * inv, o[et][4 * g4 + 1] * inv), pk2(o[et][4 * g4 + 2] * inv, o[et][4 * g4 + 3] * inv)};
        *(u32x2*)(pp + et * 32 + 8 * g4 + 4 * hh) = ov;
      }
  } else {
    const float l0 = p.LSE_()[t * 8 + h], l1 = p.LSE_()[((size_t)T_ + t) * 8 + h];
    const float mxl = fmaxf(fmaxf(l0, l1), lse);
    const float w0 = ex2(l0 - mxl), w1 = ex2(l1 - mxl), w2 = ex2(lse - mxl), rd = 1.f / (w0 + w1 + w2);
    const float f0 = w0 * rd, f1 = w1 * rd, f2 = w2 * rd * inv;
    const bf16_t* p0 = (const bf16_t*)p.out + t * 512 + h * 64;
    const bf16_t* p1 = (const bf16_t*)p.out + ((size_t)T_ + t) * 512 + h * 64;
#pragma unroll
    for (int et = 0; et < 2; ++et)
#pragma unroll
      for (int g4 = 0; g4 < 4; ++g4) {
        const int e = et * 32 + 8 * g4 + 4 * hh;
        const u32x2 a0 = *(const u32x2*)(p0 + e), a1 = *(const u32x2*)(p1 + e);
        const u32x2 gv = *(const u32x2*)(p.P_() + t * NP + CG + h * 64 + e);
        const float y0 = (o[et][4 * g4] * f2 + bflo(a0[0]) * f0 + bflo(a1[0]) * f1) * siluf(bflo(gv[0]));
        const float y1 = (o[et][4 * g4 + 1] * f2 + bfhi(a0[0]) * f0 + bfhi(a1[0]) * f1) * siluf(bfhi(gv[0]));
        const float y2 = (o[et][4 * g4 + 2] * f2 + bflo(a0[1]) * f0 + bflo(a1[1]) * f1) * siluf(bflo(gv[1]));
        const float y3 = (o[et][4 * g4 + 3] * f2 + bfhi(a0[1]) * f0 + bfhi(a1[1]) * f1) * siluf(bfhi(gv[1]));
        u32x2 ov = {pk2(y0, y1), pk2(y2, y3)};
        *(u32x2*)(p.Y_() + ((size_t)2 * T_ + t) * 512 + h * 64 + e) = ov;
      }
  }
}

DI void gla_pass1(const Params& p, int l, int it2, char* lds) {
  int tidf = threadIdx.x; asm volatile("" : "+v"(tidf));
  const int half = tidf >> 8, it = it2 * 2 + half, tid = tidf & 255, lane = tid & 63, w = tid >> 6, r = lane & 31, hh = lane >> 5;
  const int b = it >> 7, h = (it >> 5) & 3, m = it & 31;
  const size_t tok0 = (size_t)b * S_ + 64 * m;
  char* ldsh = lds + half * GLA_HALF;
  float* Bf = (float*)ldsh;
  bf16_t* Qh = (bf16_t*)(ldsh + 16640);
  bf16_t* Kh = Qh + 64 * 72;
  bf16_t* KeT = Kh + 64 * 72;
  bf16_t* Vt = KeT + 64 * 72;
  float* dec = (float*)(Vt + 128 * 68);
  float* lrs = (float*)Qh;
  const int cg_ = tid & 15, dc = (tid >> 4) & 7, ec = tid >> 4;
  const int e_w = 32 * w + r, dcol = tid & 63, cq = tid >> 6;
  u32x4 qk[4];
  {
    u32x4 vv[4];
#pragma unroll
    for (int i = 0; i < 4; ++i) {
      const size_t tok1 = tok0 + 4 * cg_ + i;
      qk[i] = *(const u32x4*)(p.P_() + tok1 * NP + (tid < 128 ? AK : AQ) + h * 64 + dc * 8);
      vv[i] = *(const u32x4*)(p.P_() + tok1 * NP + AV + h * 128 + ec * 8);
    }
    u32x2 tv[8]; tr4x8(vv[0], vv[1], vv[2], vv[3], tv);
#pragma unroll
    for (int x = 0; x < 8; ++x) *(u32x2*)(Vt + (ec * 8 + x) * 68 + 4 * cg_) = tv[x];
  }
  f32x16 o0 = zero16(), o1 = zero16();
#pragma unroll
  for (int dir = 0; dir < 2; ++dir) {
  float up[16];
#pragma unroll
  for (int i = 0; i < 16; ++i) up[i] = p.gate_up[((size_t)(l * 2 + dir) * 16 + i) * 256 + h * 64 + dcol];
  const float bias = p.gate_b[(l * 2 + dir) * 256 + h * 64 + dcol];
  {
    const int c2 = tid >> 2;
    const u32x2 lv = *(const u32x2*)(p.P_() + (tok0 + c2) * NP + LF + dir * 16 + (tid & 3) * 4);
    f32x4 lf = {bflo(lv[0]), bfhi(lv[0]), bflo(lv[1]), bfhi(lv[1])};
    *(f32x4*)(lrs + c2 * 16 + (tid & 3) * 4) = lf;
  }
  __syncthreads();
#pragma unroll 4
  for (int i = 0; i < 16; ++i) {
    const int c = cq * 16 + i;
    float z = bias;
#pragma unroll
    for (int q4 = 0; q4 < 4; ++q4) {
      const f32x4 lv = *(const f32x4*)(lrs + c * 16 + q4 * 4);
      z += lv[0] * up[4 * q4] + lv[1] * up[4 * q4 + 1] + lv[2] * up[4 * q4 + 2] + lv[3] * up[4 * q4 + 3];
    }
    Bf[c * 65 + dcol] = logsig(z) * (1.f / 16.f);
  }
  __syncthreads();
  if (tid < 64) {
    float acc = 0.f;
#pragma unroll 1
    for (int c0 = 0; c0 < 64; c0 += 8) {
      float v[8];
#pragma unroll
      for (int j = 0; j < 8; ++j) { const int c = dir ? 63 - (c0 + j) : c0 + j; v[j] = Bf[c * 65 + tid]; }
#pragma unroll
      for (int j = 0; j < 8; ++j) { const int c = dir ? 63 - (c0 + j) : c0 + j; acc += v[j]; Bf[c * 65 + tid] = acc; }
    }
  }
  __syncthreads();
  {
    const int CL = dir ? 0 : 63;
    float bl[8];
#pragma unroll
    for (int x = 0; x < 8; ++x) bl[x] = Bf[CL * 65 + dc * 8 + x];
    if (tid < 128) {
      float ke[4][8];
#pragma unroll
      for (int i = 0; i < 4; ++i) {
        const int c = 4 * cg_ + i;
        float kv[8] = {bflo(qk[i][0]), bfhi(qk[i][0]), bflo(qk[i][1]), bfhi(qk[i][1]), bflo(qk[i][2]), bfhi(qk[i][2]), bflo(qk[i][3]), bfhi(qk[i][3])};
        float kh[8];
#pragma unroll
        for (int x = 0; x < 8; ++x) { const float bb = Bf[c * 65 + dc * 8 + x]; kh[x] = kv[x] * __expf(-bb); ke[i][x] = kv[x] * __expf(bl[x] - bb); }
        u32x4 o = {pk2(kh[0], kh[1]), pk2(kh[2], kh[3]), pk2(kh[4], kh[5]), pk2(kh[6], kh[7])};
        *(u32x4*)(Kh + c * 72 + dc * 8) = o;
      }
#pragma unroll
      for (int x = 0; x < 8; ++x) {
        u32x2 o = {pk2(ke[0][x], ke[1][x]), pk2(ke[2][x], ke[3][x])};
        *(u32x2*)(KeT + (dc * 8 + x) * 72 + 4 * cg_) = o;
      }
      if (cg_ == 0) {
#pragma unroll
        for (int x = 0; x < 8; ++x) { const float dv = __expf(bl[x]); dec[dc * 8 + x] = dv; p.DEC_()[((size_t)(dir * 1024 + it)) * 64 + dc * 8 + x] = dv; }
      }
    } else {
#pragma unroll
      for (int i = 0; i < 4; ++i) {
        const int c = 4 * cg_ + i;
        float qv[8] = {bflo(qk[i][0]), bfhi(qk[i][0]), bflo(qk[i][1]), bfhi(qk[i][1]), bflo(qk[i][2]), bfhi(qk[i][2]), bflo(qk[i][3]), bfhi(qk[i][3])};
#pragma unroll
        for (int x = 0; x < 8; ++x) qv[x] *= __expf(Bf[c * 65 + dc * 8 + x]);
        u32x4 o = {pk2(qv[0], qv[1]), pk2(qv[2], qv[3]), pk2(qv[4], qv[5]), pk2(qv[6], qv[7])};
        *(u32x4*)(Qh + c * 72 + dc * 8) = o;
        *(u32x4*)(p.QH_() + ((size_t)(dir * 1024 + it) * 64 + c) * 64 + dc * 8) = o;
      }
    }
  }
  __syncthreads();
  f32x16 aD0 = zero16(), aD1 = zero16(), aX = zero16();
#pragma unroll
  for (int ks = 0; ks < 4; ++ks) {
    const bf16x8 kf0 = *(const bf16x8*)(Kh + r * 72 + ks * 16 + hh * 8), kf1 = *(const bf16x8*)(Kh + (32 + r) * 72 + ks * 16 + hh * 8);
    const bf16x8 qf0 = *(const bf16x8*)(Qh + r * 72 + ks * 16 + hh * 8), qf1 = *(const bf16x8*)(Qh + (32 + r) * 72 + ks * 16 + hh * 8);
    aD0 = MFMA32(kf0, qf0, aD0); aD1 = MFMA32(kf1, qf1, aD1);
    const bf16x8 kx = dir ? kf1 : kf0, qx = dir ? qf0 : qf1;
    aX = MFMA32(kx, qx, aX);
  }
#pragma unroll
  for (int i = 0; i < 16; ++i) { const bool keep = dir ? (crow(i, hh) >= r) : (crow(i, hh) <= r); aD0[i] = keep ? aD0[i] : 0.f; aD1[i] = keep ? aD1[i] : 0.f; }
  const bf16_t* vrow = Vt + e_w * 68;
#pragma unroll
  for (int s = 0; s < 2; ++s) {
    const bf16x8 vb0 = cat2(*(const u32x2*)(vrow + s * 16 + hh * 4), *(const u32x2*)(vrow + s * 16 + hh * 4 + 8));
    const bf16x8 vb1 = cat2(*(const u32x2*)(vrow + 32 + s * 16 + hh * 4), *(const u32x2*)(vrow + 32 + s * 16 + hh * 4 + 8));
    o0 = MFMA32(pack_step(aD0, s), vb0, o0);
    o1 = MFMA32(pack_step(aD1, s), vb1, o1);
    const bf16x8 px = pack_step(aX, s);
    if (dir == 0) o1 = MFMA32(px, vb0, o1); else o0 = MFMA32(px, vb1, o0);
  }
  f32x16 S0 = zero16(), S1 = zero16();
#pragma unroll
  for (int ks = 0; ks < 4; ++ks) {
    const bf16x8 vbn = cat2(*(const u32x2*)(vrow + ks * 16 + hh * 8), *(const u32x2*)(vrow + ks * 16 + hh * 8 + 4));
    const bf16x8 ka0 = *(const bf16x8*)(KeT + r * 72 + ks * 16 + hh * 8), ka1 = *(const bf16x8*)(KeT + (32 + r) * 72 + ks * 16 + hh * 8);
    S0 = MFMA32(ka0, vbn, S0); S1 = MFMA32(ka1, vbn, S1);
  }
  {
    bf16_t* up_ = p.UT_() + ((size_t)(dir * 1024 + it) * 128 + e_w) * 64;
#pragma unroll
    for (int g4 = 0; g4 < 4; ++g4) {
      u32x2 v0 = {pk2(S0[4 * g4], S0[4 * g4 + 1]), pk2(S0[4 * g4 + 2], S0[4 * g4 + 3])};
      u32x2 v1 = {pk2(S1[4 * g4], S1[4 * g4 + 1]), pk2(S1[4 * g4 + 2], S1[4 * g4 + 3])};
      *(u32x2*)(up_ + 8 * g4 + 4 * hh) = v0; *(u32x2*)(up_ + 32 + 8 * g4 + 4 * hh) = v1;
    }
  }
  __syncthreads();
  }
#pragma unroll
  for (int i = 0; i < 16; ++i) {
    p.OA_()[(tok0 + crow(i, hh)) * 512 + h * 128 + e_w] = o0[i];
    p.OA_()[(tok0 + 32 + crow(i, hh)) * 512 + h * 128 + e_w] = o1[i];
  }
}

DI void gla_scan(const Params& p) {
  int tid = threadIdx.x; asm volatile("" : "+v"(tid));
  for (int g = blockIdx.x * NT + tid; g < 65536; g += gridDim.x * NT) {
    const int dir = g >> 15, bh = (g >> 10) & 31, ch = g & 1023, d0 = (ch * 8) & 63;
    float st[8];
#pragma unroll
    for (int x = 0; x < 8; ++x) st[x] = 0.f;
#pragma unroll 8
    for (int step = 0; step < 32; ++step) {
      const int m = dir ? 31 - step : step, it = bh * 32 + m;
      bf16_t* ptr = p.UT_() + (size_t)(dir * 1024 + it) * 8192 + ch * 8;
      const u32x4 u = *(const u32x4*)ptr;
      const float* dp = p.DEC_() + (size_t)(dir * 1024 + it) * 64 + d0;
      const f32x4 da = *(const f32x4*)dp, db = *(const f32x4*)(dp + 4);
      u32x4 o = {pk2(st[0], st[1]), pk2(st[2], st[3]), pk2(st[4], st[5]), pk2(st[6], st[7])};
      *(u32x4*)ptr = o;
      st[0] = da[0] * st[0] + bflo(u[0]); st[1] = da[1] * st[1] + bfhi(u[0]); st[2] = da[2] * st[2] + bflo(u[1]); st[3] = da[3] * st[3] + bfhi(u[1]);
      st[4] = db[0] * st[4] + bflo(u[2]); st[5] = db[1] * st[5] + bfhi(u[2]); st[6] = db[2] * st[6] + bflo(u[3]); st[7] = db[3] * st[7] + bfhi(u[3]);
    }
  }
}

DI void gla_pass3(const Params& p, int l, int it2, char* lds) {
  int tidf = threadIdx.x; asm volatile("" : "+v"(tidf));
  const int half = tidf >> 8, tid = tidf & 255, lane = tid & 63, w = tid >> 6, r = lane & 31, hh = lane >> 5;
  const int it = it2 * 2 + half;
  const int b = it >> 7, h = (it >> 5) & 3, m = it & 31;
  const size_t tok0 = (size_t)b * S_ + 64 * m;
  float* ot = (float*)(lds + half * 34816);
  f32x16 o0, o1;
#pragma unroll
  for (int i = 0; i < 16; ++i) {
    o0[i] = p.OA_()[(tok0 + crow(i, hh)) * 512 + h * 128 + 32 * w + r];
    o1[i] = p.OA_()[(tok0 + 32 + crow(i, hh)) * 512 + h * 128 + 32 * w + r];
  }
#pragma unroll
  for (int dir = 0; dir < 2; ++dir) {
    const bf16_t* qb = p.QH_() + (size_t)(dir * 1024 + it) * 4096;
    const bf16_t* sbp = p.UT_() + ((size_t)(dir * 1024 + it) * 128 + 32 * w + r) * 64;
#pragma unroll
    for (int ks = 0; ks < 4; ++ks) {
      const bf16x8 qa0 = *(const bf16x8*)(qb + r * 64 + ks * 16 + hh * 8), qa1 = *(const bf16x8*)(qb + (32 + r) * 64 + ks * 16 + hh * 8);
      const bf16x8 sv = *(const bf16x8*)(sbp + ks * 16 + hh * 8);
      o0 = MFMA32(qa0, sv, o0); o1 = MFMA32(qa1, sv, o1);
    }
  }
#pragma unroll
  for (int i = 0; i < 16; ++i) { ot[crow(i, hh) * 132 + 32 * w + r] = o0[i]; ot[(32 + crow(i, hh)) * 132 + 32 * w + r] = o1[i]; }
  unsigned gvv[16];
#pragma unroll
  for (int k = 0; k < 16; ++k) gvv[k] = *(const unsigned*)(p.P_() + (tok0 + w * 16 + k) * NP + AG + h * 128 + 2 * lane);
  __syncthreads();
  float* ssq = ot + 64 * 132;
  {
    const int c = tid & 63, q = tid >> 6;
    float part = 0.f;
#pragma unroll
    for (int j = 0; j < 8; ++j) { const f32x4 v = *(const f32x4*)(ot + c * 132 + 32 * q + 4 * j); part += (v[0] * v[0] + v[1] * v[1]) + (v[2] * v[2] + v[3] * v[3]); }
    ssq[q * 64 + c] = part;
  }
  __syncthreads();
  const f32x2 gn = *(const f32x2*)(p.gla_norm_g + l * 128 + 2 * lane);
#pragma unroll
  for (int k = 0; k < 16; ++k) {
    const int c = w * 16 + k;
    const size_t tok = tok0 + c;
    const f32x2 v = *(const f32x2*)(ot + c * 132 + 2 * lane);
    const float ss = (ssq[c] + ssq[64 + c]) + (ssq[128 + c] + ssq[192 + c]);
    const float sc = rsqrtf(ss * (1.f / 128.f) + EPS);
    const unsigned gv = gvv[k];
    *(unsigned*)(p.Y_() + tok * 512 + h * 128 + 2 * lane) = pk2(v[0] * sc * gn[0] * siluf(bflo(gv)), v[1] * sc * gn[1] * siluf(bfhi(gv)));
  }
}

template <int ONLY> DI void phase_m1(const Params& p, int l, char* lds) {
  for (int id = blockIdx.x; id < 2048; id += gridDim.x) {
    if (id < 512) {
      const int c = id & 255, k = id >> 8, xcd = c & 7, slot = c >> 3, bh = xcd * 4 + (slot >> 3), qblk = (slot & 7) + 8 * k;
      if (ONLY == 0 || ONLY == 1) diff_item(p, l, bh >> 2, bh & 3, qblk, lds);
    }
    else if (id < 1024) { if (ONLY == 0 || ONLY == 2) gla_pass1(p, l, id - 512, lds); }
    else if (id < 1536) { if (ONLY == 0 || ONLY == 3) dil_item<0>(p, id - 1024, lds); }
    else { if (ONLY == 0 || ONLY == 3) dil_item<1>(p, id - 1536, lds); }
    __syncthreads();
  }
}
DI void phase_m3(const Params& p, int l, char* lds) {
  for (int id = blockIdx.x; id < 1024; id += gridDim.x) {
    if (id < 512) dil_item<2>(p, id, lds);
    else gla_pass3(p, l, id - 512, lds);
    __syncthreads();
  }
}

DI void phase_final(const Params& p) {
  int tid = threadIdx.x; asm volatile("" : "+v"(tid)); const int lane = tid & 63;
  const int gw = (blockIdx.x * NT + tid) >> 6, nw = gridDim.x * (NT / 64);
  const float* SSl = p.SS_() + (size_t)4 * T_ * 16;
  for (int t = gw; t < T_; t += nw) {
    const float rs = row_rs(SSl, t);
#pragma unroll
    for (int i = 0; i < 4; ++i) {
      const u32x2 xb = *(const u32x2*)(p.XB_() + (size_t)t * DM + i * 256 + lane * 4);
      const f32x4 g = *(const f32x4*)(p.final_g + i * 256 + lane * 4);
      f32x4 v = {bflo(xb[0]) * rs * g[0], bfhi(xb[0]) * rs * g[1], bflo(xb[1]) * rs * g[2], bfhi(xb[1]) * rs * g[3]};
      *(f32x4*)(p.out + (size_t)t * DM + i * 256 + lane * 4) = v;
    }
  }
}

#if DEBUG_CHECK
DI unsigned hsh(unsigned x) { x ^= x >> 16; x *= 0x7feb352du; x ^= x >> 15; x *= 0x846ca68bu; x ^= x >> 16; return x; }
DI void flag_err(const Params& p, int stage, float got, float ref, float tol) {
  const float e = fabsf(got - ref);
  atomicAdd(p.cnt_() + 16 + stage, 1);
  if (!(e <= tol * fabsf(ref) + tol)) atomicAdd(p.cnt_() + 32 + stage, 1);
}
DI void chk_weights(const Params& p) {
  const int gt = blockIdx.x * NT + threadIdx.x;
  if (gt >= 2048) return;
  const unsigned hv = hsh(gt * 3u + 1u);
  const int l = hv & 3, k = (hv >> 2) & 1023; int n = (hv >> 12) % NP;
  if (gt < 64) n = LF - 8 + gt;
  const int col = win_col(n); const float cs = win_scale(n);
  const float ref = col < 0 ? 0.f : p.w_in[((size_t)l * 1024 + k) * 8736 + col] * p.norm_g[l * 1024 + k] * cs;
  flag_err(p, 1, bf2f(p.Wi_()[((size_t)l * NP + n) * 1024 + k]), ref, 0.01f);
  const int g = hv % 3, kb = (hv >> 5) & 511, nb = (hv >> 14) & 1023;
  flag_err(p, 1, bf2f(p.Wb_()[((size_t)(l * 3 + g) * 1024 + nb) * 512 + kb]), p.w_branch[(((size_t)(l * 3 + g)) * 512 + kb) * 1024 + nb], 0.01f);
  flag_err(p, 1, bf2f(p.Wo_()[((size_t)l * 1024 + nb) * 1024 + k]), p.w_out[((size_t)l * 1024 + k) * 1024 + nb], 0.01f);
}
DI float chk_proj_raw(const Params& p, int l, int t, int n) {
  const int col = n < 1536 ? n : (n < LF ? n + 32 : (n < LF + 32 ? n - LF + 1536 : -1));
  if (col < 0) return 0.f;
  float s = 0.f;
  for (int k = 0; k < 1024; ++k) {
    const float wv = p.w_in[((size_t)l * 1024 + k) * 8736 + col] * p.norm_g[l * 1024 + k] * win_scale(n);
    s += bf2f(p.XB_()[(size_t)t * DM + k]) * bf2f((bf16_t)(pk2(wv, 0.f) & 0xffff));
  }
  return s * row_rs(p.SS_() + (size_t)l * T_ * 16, t);
}
DI void chk_inproj(const Params& p, int l) {
  const int gt = blockIdx.x * NT + threadIdx.x;
  if (gt >= 512) return;
  const unsigned hv = hsh(gt * 7u + 13u + l);
  const int t = hv & (T_ - 1); int n = (hv >> 14) % 8736;
  if (gt < 128) n = BQ + (hv >> 14) % 1024;
  else if (gt < 256) n = CQ + (hv >> 14) % 1024;
  float ref = chk_proj_raw(p, l, t, n);
  const bool rope = (n >= BQ && n < BV) || (n >= CQ && n < CV);
  if (rope) {
    const int d = n & 63, dd = d & 31;
    const float other = chk_proj_raw(p, l, t, d < 32 ? n + 32 : n - 32);
    const float ang = (float)(t & (S_ - 1)) * (1.0f / powf(10000.f, (float)(2 * dd) / 64.f));
    const float cs = cosf(ang), sn = sinf(ang);
    ref = d < 32 ? ref * cs - other * sn : ref * cs + other * sn;
  }
  flag_err(p, 2, bf2f(p.P_()[(size_t)t * NP + n]), ref, 0.03f);
}
DI void chk_gla(const Params& p, int l, char* lds) {
  if (blockIdx.x >= 16) return;
  int tid = threadIdx.x & 255; asm volatile("" : "+v"(tid));
  const unsigned hv = hsh(blockIdx.x * 11u + 5u + l);
  const int b = hv & 7, h = (hv >> 3) & 3;
  int t = (hv >> 5) & (S_ - 1);
  t = (blockIdx.x & 1) ? (t & 255) : (S_ - 1 - (t & 255));
  if (blockIdx.x < 4) t = (blockIdx.x & 1) ? 300 + (hv >> 20) % 200 : S_ - 1 - 300 - (hv >> 20) % 200;
  float* kq = (float*)lds;
  float* kk = kq; float* qq = kq + 64; float* aa = kq + 128; float* vv = kq + 192; float* red = kq + 320;
  const int e = tid & 127, dh = tid >> 7;
  float otot = 0.f;
  for (int dir = 0; dir < 2; ++dir) {
    float st[32];
#pragma unroll
    for (int i = 0; i < 32; ++i) st[i] = 0.f;
    const int nsteps = dir == 0 ? t + 1 : S_ - t;
    for (int s = 0; s < nsteps; ++s) {
      const int tau = dir == 0 ? s : S_ - 1 - s;
      const size_t tok = (size_t)b * S_ + tau;
      __syncthreads();
      if (tid < 64) {
        float z = p.gate_b[(l * 2 + dir) * 256 + h * 64 + tid];
        for (int rk = 0; rk < 16; ++rk) z += bf2f(p.P_()[tok * NP + LF + dir * 16 + rk]) * p.gate_up[((size_t)(l * 2 + dir) * 16 + rk) * 256 + h * 64 + tid];
        aa[tid] = expf(logsig(z) * (1.f / 16.f));
        kk[tid] = bf2f(p.P_()[tok * NP + AK + h * 64 + tid]);
        qq[tid] = bf2f(p.P_()[tok * NP + AQ + h * 64 + tid]);
      } else if (tid < 192) vv[tid - 64] = bf2f(p.P_()[tok * NP + AV + h * 128 + tid - 64]);
      __syncthreads();
      const float ve = vv[e];
#pragma unroll
      for (int i = 0; i < 32; ++i) st[i] = aa[dh * 32 + i] * st[i] + kk[dh * 32 + i] * ve;
    }
    float part = 0.f;
#pragma unroll
    for (int i = 0; i < 32; ++i) part += qq[dh * 32 + i] * st[i];
    otot += part;
  }
  __syncthreads();
  red[tid] = otot;
  __syncthreads();
  float oe = 0.f;
  if (tid < 128) { oe = red[tid] + red[tid + 128]; }
  __syncthreads();
  if (tid < 128) red[tid] = oe * oe;
  __syncthreads();
  if (tid == 0) { float s = 0.f; for (int i = 0; i < 128; ++i) s += red[i]; red[200] = s; }
  __syncthreads();
  if (tid < 128) {
    const size_t tok = (size_t)b * S_ + t;
    const float sc = rsqrtf(red[200] * (1.f / 128.f) + EPS);
    const float ref = oe * sc * p.gla_norm_g[l * 128 + tid] * siluf(bf2f(p.P_()[tok * NP + AG + h * 128 + tid]));
    flag_err(p, 3, bf2f(p.Y_()[tok * 512 + h * 128 + tid]), ref, 0.05f);
    { const float got = bf2f(p.Y_()[tok * 512 + h * 128 + tid]);
      if (!(fabsf(got - ref) <= 0.05f * fabsf(ref) + 0.05f)) atomicOr(p.cnt_() + 50, (1 << ((t >> 6) & 1)) | (4 << (blockIdx.x & 1))); }
  }
  __syncthreads();
}
DI void chk_diff(const Params& p, int l, char* lds) {
  if (blockIdx.x < 16 || blockIdx.x >= 48) return;
  int tid = threadIdx.x < 256 ? (int)threadIdx.x : 1000000; asm volatile("" : "+v"(tid));
  const bool act = tid < 256;
  const unsigned hv = hsh(blockIdx.x * 17u + 3u + l);
  const int b = hv & 7, h = (hv >> 3) & 3, q = (hv >> 5) & (S_ - 1);
  float* w0 = (float*)lds; float* w1 = w0 + 2048; float* red = w1 + 2048;
  const size_t tq = (size_t)b * S_ + q;
  float mx0 = -1e30f, mx1 = -1e30f;
  for (int k = tid; k < S_; k += 256) {
    const size_t tk = (size_t)b * S_ + k;
    float s0 = 0.f, s1 = 0.f;
    for (int d = 0; d < 64; ++d) {
      s0 += bf2f(p.P_()[tq * NP + BQ + h * 128 + d]) * bf2f(p.P_()[tk * NP + BKc + h * 128 + d]);
      s1 += bf2f(p.P_()[tq * NP + BQ + h * 128 + 64 + d]) * bf2f(p.P_()[tk * NP + BKc + h * 128 + 64 + d]);
    }
    w0[k] = s0; w1[k] = s1; mx0 = fmaxf(mx0, s0); mx1 = fmaxf(mx1, s1);
  }
  if (act) { red[tid] = mx0; red[256 + tid] = mx1; }
  __syncthreads();
  if (tid == 0) { float a = -1e30f, c = -1e30f; for (int i = 0; i < 256; ++i) { a = fmaxf(a, red[i]); c = fmaxf(c, red[256 + i]); } red[512] = a; red[513] = c; }
  __syncthreads();
  mx0 = red[512]; mx1 = red[513];
  float l0 = 0.f, l1 = 0.f;
  for (int k = tid; k < S_; k += 256) { const float a = exp2f(w0[k] - mx0), c = exp2f(w1[k] - mx1); w0[k] = a; w1[k] = c; l0 += a; l1 += c; }
  __syncthreads();
  if (act) { red[tid] = l0; red[256 + tid] = l1; }
  __syncthreads();
  if (tid == 0) { float a = 0.f, c = 0.f; for (int i = 0; i < 256; ++i) { a += red[i]; c += red[256 + i]; } red[514] = a; red[515] = c; }
  __syncthreads();
  l0 = red[514]; l1 = red[515];
  const float lam = p.scal_()[l], li = p.scal_()[4 + l];
  float oe = 0.f;
  if (tid < 128) {
    float a0 = 0.f, a1 = 0.f;
    for (int k = 0; k < S_; ++k) { const float v = bf2f(p.P_()[((size_t)b * S_ + k) * NP + BV + h * 128 + tid]); a0 += w0[k] * v; a1 += w1[k] * v; }
    oe = a0 / l0 - lam * a1 / l1;
  }
  __syncthreads();
  if (tid < 128) red[tid] = oe * oe;
  __syncthreads();
  if (tid == 0) { float s = 0.f; for (int i = 0; i < 128; ++i) s += red[i]; red[600] = s; }
  __syncthreads();
  if (tid < 128) {
    const float sc = rsqrtf(red[600] * (1.f / 128.f) + EPS) * (1.f - li);
    const float ref = oe * sc * p.diff_norm_g[l * 128 + tid] * siluf(bf2f(p.P_()[tq * NP + BG + h * 128 + tid]));
    flag_err(p, 4, bf2f(p.Y_()[((size_t)T_ + tq) * 512 + h * 128 + tid]), ref, 0.05f);
  }
  __syncthreads();
}
DI void chk_dil(const Params& p, int l) {
  const int gt = blockIdx.x * NT + threadIdx.x - 48 * NT;
  if (gt < 0 || gt >= 512) return;
  const unsigned hv = hsh(gt * 29u + 7u + l);
  const int b = hv & 7, h = (hv >> 3) & 7, e = (hv >> 6) & 63; int t = (hv >> 12) & (S_ - 1);
  if (gt < 64) t = gt & 1 ? (t & 127) : S_ - 1 - (t & 127);
  const size_t tq = (size_t)b * S_ + t;
  float num = 0.f, den = 0.f, mx = -1e30f;
  for (int pass = 0; pass < 2; ++pass)
    for (int g = 0; g < 3; ++g) {
      const int D = 1 << (2 * g);
      for (int j = -64; j <= 64; ++j) {
        const int tk = t + j * D;
        if (tk < 0 || tk >= S_) continue;
        const size_t tkk = (size_t)b * S_ + tk;
        float s = 0.f;
        for (int d = 0; d < 64; ++d) s += bf2f(p.P_()[tq * NP + CQ + h * 64 + d]) * bf2f(p.P_()[tkk * NP + CK + h * 64 + d]);
        if (pass == 0) mx = fmaxf(mx, s);
        else { const float w = exp2f(s - mx); den += w; num += w * bf2f(p.P_()[tkk * NP + CV + h * 64 + e]); }
      }
    }
  const float ref = num / den * siluf(bf2f(p.P_()[tq * NP + CG + h * 64 + e]));
  flag_err(p, 5, bf2f(p.Y_()[((size_t)2 * T_ + tq) * 512 + h * 64 + e]), ref, 0.05f);
}
DI void chk_merge(const Params& p, int l) {
  const int gt = blockIdx.x * NT + threadIdx.x;
  if (gt >= 512) return;
  const unsigned hv = hsh(gt * 31u + 9u + l);
  const int t = hv & (T_ - 1), n = (hv >> 14) & 1023;
  float ref = 0.f;
  for (int g = 0; g < 3; ++g) {
    float s = 0.f;
    for (int k = 0; k < 512; ++k) s += bf2f(p.Y_()[((size_t)g * T_ + t) * 512 + k]) * bf2f(p.Wb_()[((size_t)(l * 3 + g) * 1024 + n) * 512 + k]);
    ref += s / bf2f(p.P_()[(size_t)t * NP + MG + g * 1024 + n]);
  }
  flag_err(p, 6, bf2f(p.MIX_()[(size_t)t * DM + n]), ref, 0.03f);
}
DI void chk_out(const Params& p, int l, const float* Xold, const float* Xnew) {
  const int gt = blockIdx.x * NT + threadIdx.x;
  if (gt >= 512) return;
  const unsigned hv = hsh(gt * 37u + 11u + l);
  const int t = hv & (T_ - 1), n = (hv >> 14) & 1023;
  float s = 0.f;
  for (int k = 0; k < 1024; ++k) s += bf2f(p.MIX_()[(size_t)t * DM + k]) * bf2f(p.Wo_()[((size_t)l * 1024 + n) * 1024 + k]);
  flag_err(p, 7, Xnew[(size_t)t * DM + n], Xold[(size_t)t * DM + n] + s, 0.01f);
  if (gt < 64) {
    float ss = 0.f;
    for (int k = 0; k < 1024; ++k) { const float v = Xnew[(size_t)t * DM + k]; ss += v * v; }
    { const float* q = p.SS_() + ((size_t)(l + 1) * T_ + t) * 16; float tot = 0.f; for (int j = 0; j < 16; ++j) tot += q[j]; flag_err(p, 8, tot, ss, 0.001f); }
  }
}
#endif

#define GSYNC() do { asm volatile("s_waitcnt vmcnt(0) lgkmcnt(0)" ::: "memory"); grid.sync(); __builtin_amdgcn_fence(__ATOMIC_ACQUIRE, "agent"); asm volatile("s_waitcnt vmcnt(0)" ::: "memory"); __syncthreads(); } while (0)
#define XB_TMO      128
#define XB_XCNT(j)  (256  + 64 * (j))
#define XB_XSUB(j)  (1280 + 64 * (j))
#define XB_XGEN(j)  (2304 + 64 * (j))
#define XB_TOP      3328
#define XB_TOPGEN   3392
#define XCD_BAR_WORDS 3456
#define XB_SPIN_CAP (1u << 18)

__device__ __forceinline__ unsigned xb_ld(unsigned* p)              { return __hip_atomic_load(p, __ATOMIC_RELAXED, __HIP_MEMORY_SCOPE_AGENT); }
__device__ __forceinline__ unsigned xb_add(unsigned* p, unsigned v) { return __hip_atomic_fetch_add(p, v, __ATOMIC_RELAXED, __HIP_MEMORY_SCOPE_AGENT); }
__device__ __forceinline__ unsigned xb_xcc_id() { return (unsigned)__builtin_amdgcn_s_getreg((3 << 11) | 20) & 0xFu; }
#define XB_SPIN(cond, bar) do { unsigned _sp = 0; while (cond) { __builtin_amdgcn_s_sleep(1); \
    if ((++_sp & 255u) == 0u) { if (xb_ld(&(bar)[XB_TMO])) break; if (_sp > XB_SPIN_CAP) { atomicAdd(&(bar)[XB_TMO], 1u); break; } } } } while (0)

struct XcdBarrier {
    unsigned* bar; unsigned x;
    volatile PG8_LAS unsigned* st;
};

__device__ __forceinline__ XcdBarrier xcd_barrier_post(unsigned* bar, volatile PG8_LAS unsigned* st) {
    XcdBarrier b; b.bar = bar; b.x = xb_xcc_id(); b.st = st;
    if (threadIdx.x == 0) (void)xb_add(&bar[XB_XCNT(b.x)], 1u);
    return b;
}
__device__ __forceinline__ void xcd_barrier_complete(unsigned* bar, unsigned x, unsigned& nloc, unsigned& nx) {
    const unsigned G = gridDim.x * gridDim.y * gridDim.z;
    unsigned sum, cnt, mine, sp = 0u;
    for (;;) {
        sum = 0u; cnt = 0u; mine = 0u;
#pragma unroll
        for (unsigned j = 0; j < 16; ++j) { const unsigned c = xb_ld(&bar[XB_XCNT(j)]); sum += c; cnt += (c > 0u) ? 1u : 0u; mine = (j == x) ? c : mine; }
        if (sum == G) break;
        __builtin_amdgcn_s_sleep(1);
        if ((++sp & 255u) == 0u) { if (xb_ld(&bar[XB_TMO])) break; if (sp > XB_SPIN_CAP) { atomicAdd(&bar[XB_TMO], 1u); break; } }
    }
    nloc = mine > 0u ? mine : 1u; nx = cnt > 0u ? cnt : 1u;
}

__device__ __forceinline__ void xcd_barrier(const XcdBarrier& b) {
    asm volatile("s_waitcnt vmcnt(0)" ::: "memory");
    __syncthreads();
    if (threadIdx.x == 0) {
        unsigned* bar = b.bar;
        __builtin_amdgcn_s_waitcnt(0);
        unsigned nloc = b.st[0], nx = b.st[1];
        if (nloc == 0u) { xcd_barrier_complete(bar, b.x, nloc, nx); b.st[0] = nloc; b.st[1] = nx; }
        const unsigned old = xb_add(&bar[XB_XSUB(b.x)], 1u);
        const unsigned gen = old / nloc;
        if (old + 1u == (gen + 1u) * nloc) {
            __builtin_amdgcn_fence(__ATOMIC_RELEASE, "agent");
            asm volatile("s_waitcnt vmcnt(0)" ::: "memory");
            const unsigned og = xb_add(&bar[XB_TOP], 1u);
            const unsigned tg = og / nx;
            if (og + 1u == (tg + 1u) * nx) xb_add(&bar[XB_TOPGEN], 1u);
            else XB_SPIN(xb_ld(&bar[XB_TOPGEN]) == tg, bar);
            __builtin_amdgcn_fence(__ATOMIC_ACQUIRE, "agent");
            xb_add(&bar[XB_XGEN(b.x)], 1u);
            asm volatile("s_waitcnt vmcnt(0)" ::: "memory");
        } else {
            XB_SPIN(xb_ld(&bar[XB_XGEN(b.x)]) == gen, bar);
            __builtin_amdgcn_fence(__ATOMIC_ACQUIRE, "agent");
            asm volatile("s_waitcnt vmcnt(0)" ::: "memory");
        }
    }
    __syncthreads();
}
#define GBAR() do { XcdBarrier xb_ = xbar; unsigned xx_ = xb_.x; asm volatile("" : "+s"(xx_)); xb_.x = xx_; xcd_barrier(xb_); } while (0)
__global__ void __launch_bounds__(NT, 2) fwd_megakernel(Params p) {
  char* lds = g_lds;
  cg::grid_group grid = cg::this_grid();
  PG8_LAS unsigned char* lds3 = (PG8_LAS unsigned char*)lds;
  volatile PG8_LAS unsigned* xst = (volatile PG8_LAS unsigned*)(lds3 + ITEM_OFF);
  if (threadIdx.x == 0) { xst[0] = 0u; xst[1] = 0u; }
  __syncthreads();
  const XcdBarrier xbar = xcd_barrier_post((unsigned*)(p.ws + OFF_BAR), xst);
  prologue(p, lds);
  GSYNC();
#if DEBUG_CHECK && DBG_W
  chk_weights(p);
#endif
  const float* Xold = p.x;
  for (int l = 0; l < DEPTH; ++l) {
    float* Xnew = p.out;
    {
      pg8::Gemm g{p.XB_(), p.Wi_() + (size_t)l * NP * 1024, T_, NP, 1024}; pg8::StaticOrder S; S.init(T_, NP, (int)gridDim.x, (int)blockIdx.x);
      {
        PG8_LAS float* rsT = (PG8_LAS float*)(lds3 + 131072);
        PG8_LAS int* ulist = (PG8_LAS int*)(lds3 + 131072 + 14336);
        int tid = threadIdx.x; asm volatile("" : "+v"(tid));
        const float* SSl = p.SS_() + (size_t)l * T_ * 16;
        if (tid < 16) { pg8::Unit u; u.pm = 0; u.pn = 0; const bool ok = tid < 14 && S.next(tid, u); ulist[tid] = ok ? ((u.pm << 8) | u.pn) : -1; }
        __syncthreads();
        for (int idx = tid; idx < 14 * 256; idx += NT) { const int key = ulist[idx >> 8]; if (key >= 0) rsT[idx] = row_rs(SSl, (key >> 8) * 256 + (idx & 255)); }
        __syncthreads();
      }
      EpiInproj E{p.P_()};
      pg8::gemm_phase<EpiInproj, pg8::StaticOrder, INPROJ_ALIGN, DBG_SP2>(lds3, g, S, E);
#if PROBE_REP == 5
      GBAR();
      pg8::gemm_phase<EpiInproj, pg8::StaticOrder, true, DBG_SP2>(lds3, g, S, E);
#endif
#if PROBE_REP == 8
      GBAR();
      { EpiNullProbe E2{p.scal_() + 32, p.scal_() + 16, p.SS_() + (size_t)l * T_ * 16}; pg8::gemm_phase<EpiNullProbe, pg8::StaticOrder, true, DBG_SP2>(lds3, g, S, E2); }
#endif
    }
    GBAR();
#if DEBUG_CHECK && DBG_IN
    chk_inproj(p, l);
#endif
    phase_m1<0>(p, l, lds);
#if PROBE_REP >= 1 && PROBE_REP <= 4
    GBAR();
    if (blockIdx.x == 0 && threadIdx.x == 0) p.cnt_()[l] = 0;
    GBAR();
    phase_m1<(PROBE_REP & 3)>(p, l, lds);
#endif
    GBAR();
    gla_scan(p);
    GBAR();
    phase_m3(p, l, lds);
#if PROBE_REP == 7
    GBAR(); GBAR(); GBAR(); GBAR(); GBAR(); GBAR(); GBAR(); GBAR();
#endif
#if PROBE_REP == 6
    GBAR();
    if (blockIdx.x == 0 && threadIdx.x == 0) p.cnt_()[4 + l] = 0;
    GBAR();
    phase_m3(p, l, lds);
#endif
    GBAR();
#if DEBUG_CHECK
#if DBG_GLA
    chk_gla(p, l, lds);
#endif
#if DBG_DIFF
    chk_diff(p, l, lds);
#endif
#if DBG_DIL
    chk_dil(p, l);
#endif
    __syncthreads();
#endif
    {
      pg8::Gemm g{p.Y_(), p.Wb_() + (size_t)l * 3 * 1024 * 512, 3 * T_, 3 * 1024, 512}; MergeOrder S{(int)gridDim.x, (int)blockIdx.x};
      EpiMerge E{p.P_(), p.MIX_()};
#ifndef NO_MERGE
      pg8::gemm_phase<EpiMerge, MergeOrder, true, DBG_SP2>(lds3, g, S, E);
#endif
    }
    GBAR();
#if DEBUG_CHECK && DBG_MERGE
    chk_merge(p, l);
#endif
    {
      pg8::Gemm g{p.MIX_(), p.Wo_() + (size_t)l * 1024 * 1024, T_, 1024, 1024}; pg8::StaticOrder S; S.init(T_, 1024, (int)gridDim.x, (int)blockIdx.x);
      EpiOut E{l == 0 ? p.x : nullptr, p.XB_(), p.SS_() + (size_t)(l + 1) * T_ * 16};
#ifndef NO_OUT
      pg8::gemm_phase<EpiOut, pg8::StaticOrder, true, DBG_SP2>(lds3, g, S, E);
#endif
    }
    GBAR();
#if DEBUG_CHECK
    GBAR();
#endif
    Xold = Xnew;
  }
  phase_final(p);
#if DEBUG_CHECK
  GBAR();
  if (blockIdx.x == 0 && threadIdx.x == 0) {
    for (int s = 1; s < 16; ++s) {
      const int tot = p.cnt_()[16 + s], bad = p.cnt_()[32 + s];
      if (bad > 0) { int dec = (bad * 10) / (tot > 0 ? tot : 1); if (dec > 9) dec = 9; p.out[0] = 1000.f * s + 100.f * dec;
        if (s == 3) p.out[0] = 100.f * (float)(1 + (p.cnt_()[50] & 15));
        break; }
    }
  }
#endif
}

extern "C" void kernel_launch(void* const* d_in, const int* in_sizes, int n_in, void* d_out, int out_size,
                              void* d_ws, size_t ws_size, hipStream_t stream) {
  static int grid_blocks = 0;
  if (!grid_blocks) {
    int dev = 0, cus = 0, per_cu = 0;
    (void)hipGetDevice(&dev);
    (void)hipDeviceGetAttribute(&cus, hipDeviceAttributeMultiprocessorCount, dev);
    if (hipFuncSetAttribute((const void*)fwd_megakernel, hipFuncAttributeMaxDynamicSharedMemorySize, LDS_BYTES) != hipSuccess) fprintf(stderr, "hipFuncSetAttribute(dynamic LDS) failed\n");
    (void)hipOccupancyMaxActiveBlocksPerMultiprocessor(&per_cu, fwd_megakernel, NT, LDS_BYTES);
    (void)hipGetLastError();
    grid_blocks = cus;
  }
  Params p{};
  p.x = (const float*)d_in[0]; p.norm_g = (const float*)d_in[1]; p.w_in = (const float*)d_in[2]; p.gate_up = (const float*)d_in[3];
  p.gate_b = (const float*)d_in[4]; p.gla_norm_g = (const float*)d_in[5]; p.diff_lambda = (const float*)d_in[6]; p.diff_norm_g = (const float*)d_in[7];
  p.w_branch = (const float*)d_in[8]; p.w_out = (const float*)d_in[9]; p.final_g = (const float*)d_in[10];
  p.out = (float*)d_out;
  p.ws = (char*)d_ws;
  if (WS_END > ws_size) { fprintf(stderr, "workspace too small: need %zu have %zu\n", (size_t)WS_END, ws_size); return; }
  if (hipMemsetAsync((char*)d_ws + OFF_BAR, 0, 16384, stream) != hipSuccess) { fprintf(stderr, "barrier memset failed\n"); return; }
  void* args[] = {&p};
  hipError_t e = hipLaunchCooperativeKernel((void*)fwd_megakernel, dim3(grid_blocks), dim3(NT), args, LDS_BYTES, stream);
  if (e != hipSuccess) fprintf(stderr, "cooperative launch failed: %s (grid %d)\n", hipGetErrorString(e), grid_blocks);
}
```
